# Optimizing an MI355X kernel written in HIP

```python
import math
import jax, jax.numpy as jnp
from jax import lax
import numpy as np

D_MODEL = 1024
BATCH = 8
SEQ = 4096
DEPTH = 1

GMLP_WIDTH = D_MODEL
GMLP_GROUPS = 8
GMLP_GROUP_DIM = GMLP_WIDTH // GMLP_GROUPS
GMLP_CHUNK = 128
HGRN_HEADS = 8
HGRN_DK = 128
HGRN_DV = D_MODEL // HGRN_HEADS
HGRN_KEY_WIDTH = HGRN_HEADS * HGRN_DK
HGRN_VAL_WIDTH = HGRN_HEADS * HGRN_DV
HGRN_CHUNK = 64
HGRN_SCALE = HGRN_DK ** -0.5
N_BRANCHES = 2
D_FF = -(-(8 * D_MODEL) // (3 * 256)) * 256
IN_SIZES = (GMLP_WIDTH, GMLP_WIDTH, HGRN_KEY_WIDTH, HGRN_KEY_WIDTH,
            HGRN_VAL_WIDTH, HGRN_VAL_WIDTH, D_MODEL, D_MODEL)
IN_WIDTH = sum(IN_SIZES)
NORM_EPS = 1e-6

kernel_name = "gmlp_hgrn2_gated_hybrid_block"


def _split_points(sizes):
    pts, acc = [], 0
    for s in sizes[:-1]:
        acc += s
        pts.append(acc)
    return pts


def rms_norm(x, gain):
    xf = x.astype(jnp.float32)
    y = xf * lax.rsqrt(jnp.mean(xf * xf, axis=-1, keepdims=True) + NORM_EPS)
    return (y * gain.astype(jnp.float32)).astype(x.dtype)


def layer_norm(x, gain, bias):
    xf = x.astype(jnp.float32)
    mu = jnp.mean(xf, axis=-1, keepdims=True)
    var = jnp.mean(jnp.square(xf - mu), axis=-1, keepdims=True)
    y = (xf - mu) * lax.rsqrt(var + NORM_EPS)
    return (y * gain.astype(jnp.float32) + bias.astype(jnp.float32)).astype(x.dtype)


def gmlp_spatial_gating(u, v, ln_g, ln_b, w_s, b_s):
    B, S, _ = v.shape
    n_chunks = S // GMLP_CHUNK
    v = layer_norm(v, ln_g, ln_b)
    vc = v.reshape(B, n_chunks, GMLP_CHUNK, GMLP_GROUPS, GMLP_GROUP_DIM)
    causal = jnp.tril(jnp.ones((GMLP_CHUNK, GMLP_CHUNK), dtype=bool))
    w = jnp.where(causal, w_s, jnp.zeros((), w_s.dtype)).astype(v.dtype)
    mixed = jnp.einsum('gts,bnsgd->bntgd', w, vc) + b_s.T.astype(v.dtype)[:, :, None]
    return u * mixed.reshape(B, S, GMLP_WIDTH)


def hgrn2_chunkwise(q, f_logit, v, lb):
    B, S, _ = q.shape
    C = HGRN_CHUNK
    n_chunks = S // C
    f32 = jnp.float32
    lb = lb.astype(f32)
    f = lb + (1.0 - lb) * jax.nn.sigmoid(f_logit.astype(f32))
    k = 1.0 - f
    log_f = jnp.log(f)

    def to_chunks(t, d):
        return t.reshape(B, n_chunks, C, HGRN_HEADS, d).transpose(0, 3, 1, 2, 4)

    qc = to_chunks(q.astype(f32), HGRN_DK) * HGRN_SCALE
    kc = to_chunks(k, HGRN_DK)
    vc = to_chunks(v.astype(f32), HGRN_DV)
    A = jnp.cumsum(to_chunks(log_f, HGRN_DK), axis=3)
    A_mid = A[:, :, :, C // 2 - 1:C // 2, :]
    A_last = A[:, :, :, C - 1:C, :]

    q_in = qc * jnp.exp(A - A_mid)
    k_in = kc * jnp.exp(A_mid - A)
    causal = jnp.tril(jnp.ones((C, C), dtype=bool))
    scores = jnp.where(causal, jnp.einsum('bhctk,bhcsk->bhcts', q_in, k_in), 0.0)
    o_intra = jnp.einsum('bhcts,bhcsv->bhctv', scores, vc)

    dS = jnp.einsum('bhcsk,bhcsv->bhckv', kc * jnp.exp(A_last - A), vc)
    decay = jnp.exp(A_last[:, :, :, 0, :])

    def step(S_prev, xs):
        d, ds = xs
        return d[..., None] * S_prev + ds, S_prev

    S0 = jnp.zeros((B, HGRN_HEADS, HGRN_DK, HGRN_DV), f32)
    _, S_before = lax.scan(step, S0, (jnp.moveaxis(decay, 2, 0), jnp.moveaxis(dS, 2, 0)))
    S_before = jnp.moveaxis(S_before, 0, 2)
    o_inter = jnp.einsum('bhctk,bhckv->bhctv', qc * jnp.exp(A), S_before)

    o = o_intra + o_inter
    return o.transpose(0, 2, 3, 1, 4).reshape(B, S, HGRN_HEADS, HGRN_DV)


def setup_inputs(seed: int = 0) -> dict:
    key = jax.random.key(seed)
    ks = jax.random.split(key, 16)
    f32 = jnp.float32

    def normal(k, shape, scale):
        return jax.random.normal(k, shape, f32) * scale

    return {
        "x": normal(ks[0], (BATCH, SEQ, D_MODEL), 1.0),
        "norm_mix_g": 1.0 + normal(ks[1], (DEPTH, D_MODEL), 0.05),
        "w_in": normal(ks[2], (DEPTH, D_MODEL, IN_WIDTH), D_MODEL ** -0.5),
        "gmlp_ln_g": 1.0 + normal(ks[3], (DEPTH, GMLP_WIDTH), 0.05),
        "gmlp_ln_b": normal(ks[4], (DEPTH, GMLP_WIDTH), 0.02),
        "gmlp_w_s": normal(ks[5], (DEPTH, GMLP_GROUPS, GMLP_CHUNK, GMLP_CHUNK), GMLP_CHUNK ** -0.5),
        "gmlp_b_s": 1.0 + normal(ks[6], (DEPTH, GMLP_GROUPS, GMLP_CHUNK), 0.1),
        "hgrn_lb_table": normal(ks[7], (DEPTH + 1, HGRN_KEY_WIDTH), 0.5),
        "hgrn_norm_g": 1.0 + normal(ks[8], (DEPTH, HGRN_DV * HGRN_HEADS), 0.05),
        "w_branch_a": normal(ks[9], (DEPTH, GMLP_WIDTH, D_MODEL), GMLP_WIDTH ** -0.5),
        "w_branch_b": normal(ks[10], (DEPTH, HGRN_VAL_WIDTH, D_MODEL), HGRN_VAL_WIDTH ** -0.5),
        "w_out": normal(ks[11], (DEPTH, D_MODEL, D_MODEL), D_MODEL ** -0.5),
        "norm_ffn_g": 1.0 + normal(ks[12], (DEPTH, D_MODEL), 0.05),
        "w_gate_up": normal(ks[13], (DEPTH, D_MODEL, 2 * D_FF), D_MODEL ** -0.5),
        "w_down": normal(ks[14], (DEPTH, D_FF, D_MODEL), D_FF ** -0.5),
        "norm_final_g": 1.0 + normal(ks[15], (D_MODEL,), 0.05),
    }


def reference(x, norm_mix_g, w_in, gmlp_ln_g, gmlp_ln_b, gmlp_w_s, gmlp_b_s,
              hgrn_lb_table, hgrn_norm_g, w_branch_a, w_branch_b, w_out,
              norm_ffn_g, w_gate_up, w_down, norm_final_g):
    B, S, _ = x.shape
    split_pts = _split_points(IN_SIZES)
    lb_all = jnp.cumsum(jax.nn.softmax(hgrn_lb_table.astype(jnp.float32), axis=0), axis=0)

    for l in range(DEPTH):
        h = rms_norm(x, norm_mix_g[l])
        proj = jnp.einsum('bsd,de->bse', h, w_in[l])
        u, v, q, f_logit, i_val, g_out, gate_a, gate_b = jnp.split(proj, split_pts, axis=-1)

        a = gmlp_spatial_gating(jax.nn.gelu(u), jax.nn.gelu(v), gmlp_ln_g[l], gmlp_ln_b[l],
                                gmlp_w_s[l], gmlp_b_s[l])
        y_a = jnp.einsum('bse,ed->bsd', a, w_branch_a[l])

        o = hgrn2_chunkwise(q, f_logit, i_val, lb_all[l])
        o = o * lax.rsqrt(jnp.mean(o * o, axis=-1, keepdims=True) + NORM_EPS)
        o = (o.reshape(B, S, HGRN_VAL_WIDTH) * hgrn_norm_g[l].astype(jnp.float32)).astype(x.dtype)
        o = o * jax.nn.silu(g_out)
        y_b = jnp.einsum('bse,ed->bsd', o, w_branch_b[l])

        merged = jax.nn.sigmoid(gate_a) * y_a + jax.nn.sigmoid(gate_b) * y_b
        x = x + jnp.einsum('bsd,de->bse', merged, w_out[l])

        h = rms_norm(x, norm_ffn_g[l])
        gu = jnp.einsum('bsd,df->bsf', h, w_gate_up[l])
        gate, up = jnp.split(gu, [D_FF], axis=-1)
        x = x + jnp.einsum('bsf,fd->bsd', jax.nn.silu(gate) * up, w_down[l])

    return rms_norm(x, norm_final_g)
```

```cpp
#include <hip/hip_runtime.h>
#include <cstdint>
#include <cstdio>

typedef unsigned short bf16_t;
typedef unsigned short f16_t;

constexpr int MT = 32768, DM = 1024, NIN = 8192, DFF = 2816, SEQ = 4096, NBATCH = 8;
constexpr float EPS = 1e-6f;
constexpr float HSCALE = 0.08838834764831845f;

constexpr size_t MiB = 1u << 20;
constexpr size_t WS_CTL = 0;
constexpr size_t CTL_BYTES = 1 * MiB;
constexpr size_t CTL_VST = 256 * 1024;
constexpr size_t WS_WIN = 1 * MiB;
constexpr size_t WS_WA = 17 * MiB;
constexpr size_t WS_WB = 19 * MiB;
constexpr size_t WS_WOUT = 21 * MiB;
constexpr size_t WS_WGU = 23 * MiB;
constexpr size_t WS_WDOWN = 34 * MiB;
constexpr size_t WS_WM = 40 * MiB;
constexpr size_t WS_LB = 40 * MiB + 512 * 1024;
constexpr size_t WS_XN = 64 * MiB;
constexpr size_t WS_U = 128 * MiB;
constexpr size_t WS_V = 192 * MiB;
constexpr size_t WS_I = 256 * MiB;
constexpr size_t WS_G = 320 * MiB;
constexpr size_t WS_GA = 384 * MiB;
constexpr size_t WS_GB = 448 * MiB;
constexpr size_t WS_AACT = WS_XN, WS_OACT = WS_U, WS_MG = WS_I, WS_HN2 = WS_G, WS_X1 = WS_GA;
constexpr size_t WS_H = 64 * MiB;
constexpr size_t WS_END = 512 * MiB;
constexpr size_t OUT_Q = 0, OUT_F = 64 * MiB;

__device__ __forceinline__ float bf2f(bf16_t b) { return __uint_as_float((unsigned)b << 16); }
__device__ __forceinline__ bf16_t f2bf(float f) { unsigned u = __float_as_uint(f); return (bf16_t)((u + 0x7fffu + ((u >> 16) & 1u)) >> 16); }
__device__ __forceinline__ f16_t f2h(float f) { _Float16 h = (_Float16)f; return __builtin_bit_cast(unsigned short, h); }
__device__ __forceinline__ float h2f(f16_t u) { return (float)__builtin_bit_cast(_Float16, u); }
__device__ __forceinline__ float sigmoidf_(float x) { return 1.f / (1.f + __expf(-x)); }
__device__ __forceinline__ float siluf_(float x) { return x / (1.f + __expf(-x)); }
__device__ __forceinline__ float gelu_tanh(float x) { const float u = 1.5957691216057308f * (x + 0.044715f * x * x * x); return x / (1.f + __expf(-u)); }

struct EpiIn {
    bf16_t *U, *V, *Q, *I, *G, *GA, *GB; f16_t* F; float* VST; const float* lb;
    __device__ __forceinline__ void operator()(int row, int col, const float (&v)[8]) const {
        const int seg = col >> 10, c = col & 1023; const size_t o = (size_t)row * DM + c;
        float r[8];
        if (seg == 0) {
#pragma unroll
            for (int j = 0; j < 8; ++j) r[j] = gelu_tanh(v[j]);
            store8(U + o, r);
        } else if (seg == 1) {
            float s = 0.f, s2 = 0.f;
#pragma unroll
            for (int j = 0; j < 8; ++j) { r[j] = gelu_tanh(v[j]); s += r[j]; s2 += r[j] * r[j]; }
            store8(V + o, r);
            atomicAdd(VST + 2 * (size_t)row, s); atomicAdd(VST + 2 * (size_t)row + 1, s2);
        } else if (seg == 2) {
#pragma unroll
            for (int j = 0; j < 8; ++j) r[j] = v[j] * HSCALE;
            store8(Q + o, r);
        } else if (seg == 3) {
            unsigned w[4];
#pragma unroll
            for (int j = 0; j < 8; j += 2) {
                const float l0 = lb[c + j], l1 = lb[c + j + 1];
                const float f0 = l0 + (1.f - l0) * sigmoidf_(v[j]), f1 = l1 + (1.f - l1) * sigmoidf_(v[j + 1]);
                w[j >> 1] = (unsigned)f2h(__logf(f0)) | ((unsigned)f2h(__logf(f1)) << 16);
            }
            *(uint4*)(F + o) = make_uint4(w[0], w[1], w[2], w[3]);
        } else if (seg == 4) {
            store8(I + o, v);
        } else if (seg == 5) {
#pragma unroll
            for (int j = 0; j < 8; ++j) r[j] = siluf_(v[j]);
            store8(G + o, r);
        } else {
#pragma unroll
            for (int j = 0; j < 8; ++j) r[j] = sigmoidf_(v[j]);
            store8((seg == 6 ? GA : GB) + o, r);
        }
    }
    static __device__ __forceinline__ void store8(bf16_t* p, const float (&r)[8]) {
        uint4 w; w.x = (unsigned)f2bf(r[0]) | ((unsigned)f2bf(r[1]) << 16); w.y = (unsigned)f2bf(r[2]) | ((unsigned)f2bf(r[3]) << 16);
        w.z = (unsigned)f2bf(r[4]) | ((unsigned)f2bf(r[5]) << 16); w.w = (unsigned)f2bf(r[6]) | ((unsigned)f2bf(r[7]) << 16);
        *(uint4*)p = w;
    }
};
struct EpiBranchA {
    const bf16_t* GA; float* T;
    __device__ __forceinline__ void operator()(int row, int col, const float (&v)[8]) const {
        const size_t o = (size_t)row * DM + col; const uint4 g = *(const uint4*)(GA + o); const unsigned gw[4] = {g.x, g.y, g.z, g.w};
        float r[8];
#pragma unroll
        for (int j = 0; j < 8; ++j) r[j] = bf2f((bf16_t)(gw[j >> 1] >> (16 * (j & 1)))) * v[j];
        *(float4*)(T + o) = make_float4(r[0], r[1], r[2], r[3]); *(float4*)(T + o + 4) = make_float4(r[4], r[5], r[6], r[7]);
    }
};
struct EpiBranchB {
    const bf16_t* GB; const float* T; bf16_t* MG;
    __device__ __forceinline__ void operator()(int row, int col, const float (&v)[8]) const {
        const size_t o = (size_t)row * DM + col; const uint4 g = *(const uint4*)(GB + o); const unsigned gw[4] = {g.x, g.y, g.z, g.w};
        const float4 t0 = *(const float4*)(T + o), t1 = *(const float4*)(T + o + 4); const float t[8] = {t0.x, t0.y, t0.z, t0.w, t1.x, t1.y, t1.z, t1.w};
        float r[8];
#pragma unroll
        for (int j = 0; j < 8; ++j) r[j] = t[j] + bf2f((bf16_t)(gw[j >> 1] >> (16 * (j & 1)))) * v[j];
        EpiIn::store8(MG + o, r);
    }
};
struct EpiResid {
    const float* BASE; float* OUT;
    __device__ __forceinline__ void operator()(int row, int col, const float (&v)[8]) const {
        const size_t o = (size_t)row * DM + col; const float4 b0 = *(const float4*)(BASE + o), b1 = *(const float4*)(BASE + o + 4);
        *(float4*)(OUT + o) = make_float4(b0.x + v[0], b0.y + v[1], b0.z + v[2], b0.w + v[3]);
        *(float4*)(OUT + o + 4) = make_float4(b1.x + v[4], b1.y + v[5], b1.z + v[6], b1.w + v[7]);
    }
};
struct EpiSwiglu {
    bf16_t* H;
    __device__ __forceinline__ void pair(int row, int col, const float (&g)[8], const float (&u)[8]) const {
        float r[8];
#pragma unroll
        for (int j = 0; j < 8; ++j) r[j] = siluf_(g[j]) * u[j];
        EpiIn::store8(H + (size_t)row * DFF + col, r);
    }
};

__global__ void k_transpose(const float* W, bf16_t* WT, int K, int N) {
    const size_t i = (size_t)blockIdx.x * blockDim.x + threadIdx.x; if (i >= (size_t)K * N) return;
    const int n = (int)(i / K), k = (int)(i % K); WT[i] = f2bf(W[(size_t)k * N + n]);
}
__global__ void k_transpose_gu(const float* W, bf16_t* WT) {
    const size_t i = (size_t)blockIdx.x * blockDim.x + threadIdx.x; if (i >= (size_t)2 * DFF * DM) return;
    const int r = (int)(i / DM), k = (int)(i % DM); const int j = r >> 8, w = r & 255; const int col = (w < 128) ? (j * 128 + w) : (DFF + j * 128 + (w - 128));
    WT[i] = f2bf(W[(size_t)k * (2 * DFF) + col]);
}
__global__ void k_small(const float* ws, const float* lbt, bf16_t* WM, float* LB) {
    const int i = blockIdx.x * blockDim.x + threadIdx.x;
    if (i < 8 * 128 * 128) { const int t = (i >> 7) & 127, s = i & 127; WM[i] = (s <= t) ? f2bf(ws[i]) : (bf16_t)0; }
    if (i < 1024) { const float a = lbt[i], b = lbt[1024 + i]; const float m = fmaxf(a, b); const float ea = __expf(a - m), eb = __expf(b - m); LB[i] = ea / (ea + eb); }
}
__global__ void __launch_bounds__(256) k_rmsnorm_bf16(const float* X, const float* g, bf16_t* O) {
    const int row = blockIdx.x * 4 + (threadIdx.x >> 6), lane = threadIdx.x & 63;
    const float4* xr = (const float4*)(X + (size_t)row * DM) + lane; float4 v[4]; float s = 0.f;
#pragma unroll
    for (int j = 0; j < 4; ++j) { v[j] = xr[64 * j]; s += v[j].x * v[j].x + v[j].y * v[j].y + v[j].z * v[j].z + v[j].w * v[j].w; }
#pragma unroll
    for (int o = 1; o < 64; o <<= 1) s += __shfl_xor(s, o);
    const float r = rsqrtf(s * (1.f / DM) + EPS);
#pragma unroll
    for (int j = 0; j < 4; ++j) { const float4 gg = ((const float4*)g)[lane + 64 * j];
        uint2 w; w.x = (unsigned)f2bf(v[j].x * r * gg.x) | ((unsigned)f2bf(v[j].y * r * gg.y) << 16); w.y = (unsigned)f2bf(v[j].z * r * gg.z) | ((unsigned)f2bf(v[j].w * r * gg.w) << 16);
        ((uint2*)(O + (size_t)row * DM))[lane + 64 * j] = w; }
}
__global__ void __launch_bounds__(256) k_rmsnorm_f32(float* X, const float* g) {
    const int row = blockIdx.x * 4 + (threadIdx.x >> 6), lane = threadIdx.x & 63;
    float4* xr = (float4*)(X + (size_t)row * DM) + lane; float4 v[4]; float s = 0.f;
#pragma unroll
    for (int j = 0; j < 4; ++j) { v[j] = xr[64 * j]; s += v[j].x * v[j].x + v[j].y * v[j].y + v[j].z * v[j].z + v[j].w * v[j].w; }
#pragma unroll
    for (int o = 1; o < 64; o <<= 1) s += __shfl_xor(s, o);
    const float r = rsqrtf(s * (1.f / DM) + EPS);
#pragma unroll
    for (int j = 0; j < 4; ++j) { const float4 gg = ((const float4*)g)[lane + 64 * j]; xr[64 * j] = make_float4(v[j].x * r * gg.x, v[j].y * r * gg.y, v[j].z * r * gg.z, v[j].w * r * gg.w); }
}

template <class Epi, bool DUAL>
__global__ void __launch_bounds__(256) k_gemm_naive(const bf16_t* A, const bf16_t* Bt, int K, int ntn, Epi E) {
    __shared__ float As[64][33], Bs[64][33], Bs2[DUAL ? 64 : 1][33];
    const int t = threadIdx.x, tr = t >> 3, tc = t & 7;
    const int tm = blockIdx.x / ntn, tn = blockIdx.x % ntn;
    const int row0 = tm * 64; int brow0, col0;
    if (DUAL) { col0 = tn * 64; brow0 = (col0 >> 7) * 256 + (col0 & 127); } else { col0 = tn * 64; brow0 = col0; }
    float acc[2][8], acc2[2][8];
#pragma unroll
    for (int i = 0; i < 2; ++i)
#pragma unroll
        for (int j = 0; j < 8; ++j) { acc[i][j] = 0.f; acc2[i][j] = 0.f; }
    const int lr = t >> 2, lk = (t & 3) * 8;
    for (int k0 = 0; k0 < K; k0 += 32) {
        { const uint4 a = *(const uint4*)(A + (size_t)(row0 + lr) * K + k0 + lk); const unsigned w[4] = {a.x, a.y, a.z, a.w};
#pragma unroll
          for (int j = 0; j < 8; ++j) As[lr][lk + j] = bf2f((bf16_t)(w[j >> 1] >> (16 * (j & 1)))); }
        { const uint4 a = *(const uint4*)(Bt + (size_t)(brow0 + lr) * K + k0 + lk); const unsigned w[4] = {a.x, a.y, a.z, a.w};
#pragma unroll
          for (int j = 0; j < 8; ++j) Bs[lr][lk + j] = bf2f((bf16_t)(w[j >> 1] >> (16 * (j & 1)))); }
        if (DUAL) { const uint4 a = *(const uint4*)(Bt + (size_t)(brow0 + 128 + lr) * K + k0 + lk); const unsigned w[4] = {a.x, a.y, a.z, a.w};
#pragma unroll
          for (int j = 0; j < 8; ++j) Bs2[lr][lk + j] = bf2f((bf16_t)(w[j >> 1] >> (16 * (j & 1)))); }
        __syncthreads();
#pragma unroll 8
        for (int k = 0; k < 32; ++k) {
            const float a0 = As[tr][k], a1 = As[tr + 32][k];
#pragma unroll
            for (int j = 0; j < 8; ++j) { const float b = Bs[tc * 8 + j][k]; acc[0][j] += a0 * b; acc[1][j] += a1 * b;
                if (DUAL) { const float b2 = Bs2[tc * 8 + j][k]; acc2[0][j] += a0 * b2; acc2[1][j] += a1 * b2; } }
        }
        __syncthreads();
    }
    if constexpr (DUAL) { E.pair(row0 + tr, col0 + tc * 8, acc[0], acc2[0]); E.pair(row0 + tr + 32, col0 + tc * 8, acc[1], acc2[1]); }
    else { E(row0 + tr, col0 + tc * 8, acc[0]); E(row0 + tr + 32, col0 + tc * 8, acc[1]); }
}

__global__ void __launch_bounds__(256) k_gmlp_naive(const bf16_t* U, const bf16_t* V, const float* VST, const bf16_t* WM, const float* lng, const float* lnb, const float* bs, bf16_t* AACT) {
    __shared__ float Vl[128][128];
    const int unit = blockIdx.x, g = unit & 7, n = (unit >> 3) & 31, b = unit >> 8; const int t = threadIdx.x;
    const size_t r0 = (size_t)b * SEQ + n * 128;
    for (int i = t; i < 128 * 128; i += 256) { const int s = i >> 7, d = i & 127; const size_t row = r0 + s;
        const float mu = VST[2 * row] * (1.f / DM), var = VST[2 * row + 1] * (1.f / DM) - mu * mu; const float rs = rsqrtf(var + EPS);
        Vl[s][d] = (bf2f(V[row * DM + g * 128 + d]) - mu) * rs * lng[g * 128 + d] + lnb[g * 128 + d]; }
    __syncthreads();
    const int d = t & 127, th = t >> 7;
    for (int tt = th * 64; tt < th * 64 + 64; ++tt) {
        float acc = 0.f; const bf16_t* wr = WM + ((size_t)g * 128 + tt) * 128;
        for (int s = 0; s <= tt; ++s) acc += bf2f(wr[s]) * Vl[s][d];
        const size_t o = (r0 + tt) * DM + g * 128 + d;
        AACT[o] = f2bf(bf2f(U[o]) * (acc + bs[g * 128 + tt]));
    }
}

__global__ void __launch_bounds__(128) k_hgrn_naive(const bf16_t* Q, const f16_t* F, const bf16_t* I, const bf16_t* G, const float* ng, bf16_t* OACT) {
    __shared__ float fS[2][128], kS[2][128], qS[2][128], part[2][2];
    const int b = blockIdx.x >> 3, h = blockIdx.x & 7, v = threadIdx.x, lane = v & 63, wv = v >> 6;
    float S[128];
#pragma unroll
    for (int k = 0; k < 128; ++k) S[k] = 0.f;
    const size_t base = (size_t)b * SEQ * DM + h * 128 + v;
    { const float lf = h2f(F[base]); fS[0][v] = __expf(lf); kS[0][v] = -expm1f(lf); qS[0][v] = bf2f(Q[base]); }
    __syncthreads();
    const float gn = ng[h * 128 + v];
    for (int t = 0; t < SEQ; ++t) {
        const int buf = t & 1; const size_t idx = base + (size_t)t * DM;
        if (t + 1 < SEQ) { const float lf = h2f(F[idx + DM]); fS[buf ^ 1][v] = __expf(lf); kS[buf ^ 1][v] = -expm1f(lf); qS[buf ^ 1][v] = bf2f(Q[idx + DM]); }
        const float iv = bf2f(I[idx]); float o = 0.f;
#pragma unroll
        for (int k = 0; k < 128; ++k) { S[k] = fS[buf][k] * S[k] + kS[buf][k] * iv; o += qS[buf][k] * S[k]; }
        float ss = o * o;
#pragma unroll
        for (int off = 1; off < 64; off <<= 1) ss += __shfl_xor(ss, off);
        if (lane == 0) part[buf][wv] = ss;
        __syncthreads();
        const float r = rsqrtf((part[buf][0] + part[buf][1]) * (1.f / 128.f) + EPS);
        OACT[idx] = f2bf(o * r * gn * bf2f(G[idx]));
    }
}

extern "C" void kernel_launch(void* const* d_in, const int* in_sizes, int n_in, void* d_out, int out_size, void* d_ws, size_t ws_size, hipStream_t stream) {
    if (n_in != 16 || in_sizes[0] != MT * DM || in_sizes[2] != DM * NIN || out_size != MT * DM || ws_size < WS_END) {
        fprintf(stderr, "kernel_launch: unexpected shapes (n_in %d, in0 %d, in2 %d, out %d, ws %zu)\n", n_in, n_in > 0 ? in_sizes[0] : -1, n_in > 2 ? in_sizes[2] : -1, out_size, ws_size); return; }
    const float* x = (const float*)d_in[0]; const float* g_mix = (const float*)d_in[1]; const float* w_in = (const float*)d_in[2];
    const float* ln_g = (const float*)d_in[3]; const float* ln_b = (const float*)d_in[4]; const float* w_s = (const float*)d_in[5]; const float* b_s = (const float*)d_in[6];
    const float* lbt = (const float*)d_in[7]; const float* hn_g = (const float*)d_in[8]; const float* w_a = (const float*)d_in[9]; const float* w_b = (const float*)d_in[10];
    const float* w_out = (const float*)d_in[11]; const float* g_ffn = (const float*)d_in[12]; const float* w_gu = (const float*)d_in[13]; const float* w_down = (const float*)d_in[14];
    const float* g_fin = (const float*)d_in[15];
    unsigned char* ws = (unsigned char*)d_ws; unsigned char* ob = (unsigned char*)d_out;
    bf16_t *WtIn = (bf16_t*)(ws + WS_WIN), *WtA = (bf16_t*)(ws + WS_WA), *WtB = (bf16_t*)(ws + WS_WB), *WtOut = (bf16_t*)(ws + WS_WOUT), *WtGU = (bf16_t*)(ws + WS_WGU), *WtDown = (bf16_t*)(ws + WS_WDOWN), *WM = (bf16_t*)(ws + WS_WM);
    float* LB = (float*)(ws + WS_LB); float* VST = (float*)(ws + WS_CTL + CTL_VST);
    bf16_t *XN = (bf16_t*)(ws + WS_XN), *U = (bf16_t*)(ws + WS_U), *V = (bf16_t*)(ws + WS_V), *I = (bf16_t*)(ws + WS_I), *G = (bf16_t*)(ws + WS_G), *GA = (bf16_t*)(ws + WS_GA), *GB = (bf16_t*)(ws + WS_GB);
    bf16_t *Q = (bf16_t*)(ob + OUT_Q); f16_t* F = (f16_t*)(ob + OUT_F); float* T = (float*)d_out;
    bf16_t *AACT = (bf16_t*)(ws + WS_AACT), *OACT = (bf16_t*)(ws + WS_OACT), *MG = (bf16_t*)(ws + WS_MG), *HN2 = (bf16_t*)(ws + WS_HN2), *H = (bf16_t*)(ws + WS_H);
    float* X1 = (float*)(ws + WS_X1); float* OUT = (float*)d_out;

    hipMemsetAsync(ws + WS_CTL, 0, CTL_BYTES, stream);
    k_transpose<<<(DM * NIN + 255) / 256, 256, 0, stream>>>(w_in, WtIn, DM, NIN);
    k_transpose<<<(DM * DM + 255) / 256, 256, 0, stream>>>(w_a, WtA, DM, DM);
    k_transpose<<<(DM * DM + 255) / 256, 256, 0, stream>>>(w_b, WtB, DM, DM);
    k_transpose<<<(DM * DM + 255) / 256, 256, 0, stream>>>(w_out, WtOut, DM, DM);
    k_transpose_gu<<<(2 * DFF * DM + 255) / 256, 256, 0, stream>>>(w_gu, WtGU);
    k_transpose<<<(DFF * DM + 255) / 256, 256, 0, stream>>>(w_down, WtDown, DFF, DM);
    k_small<<<(8 * 128 * 128 + 255) / 256, 256, 0, stream>>>(w_s, lbt, WM, LB);
    k_rmsnorm_bf16<<<MT / 4, 256, 0, stream>>>(x, g_mix, XN);
    { EpiIn E{U, V, Q, I, G, GA, GB, F, VST, LB}; k_gemm_naive<EpiIn, false><<<(MT / 64) * (NIN / 64), 256, 0, stream>>>(XN, WtIn, DM, NIN / 64, E); }
    k_gmlp_naive<<<NBATCH * 32 * 8, 256, 0, stream>>>(U, V, VST, WM, ln_g, ln_b, b_s, AACT);
    k_hgrn_naive<<<NBATCH * 8, 128, 0, stream>>>(Q, F, I, G, hn_g, OACT);
    { EpiBranchA E{GA, T}; k_gemm_naive<EpiBranchA, false><<<(MT / 64) * (DM / 64), 256, 0, stream>>>(AACT, WtA, DM, DM / 64, E); }
    { EpiBranchB E{GB, T, MG}; k_gemm_naive<EpiBranchB, false><<<(MT / 64) * (DM / 64), 256, 0, stream>>>(OACT, WtB, DM, DM / 64, E); }
    { EpiResid E{x, X1}; k_gemm_naive<EpiResid, false><<<(MT / 64) * (DM / 64), 256, 0, stream>>>(MG, WtOut, DM, DM / 64, E); }
    k_rmsnorm_bf16<<<MT / 4, 256, 0, stream>>>(X1, g_ffn, HN2);
    { EpiSwiglu E{H}; k_gemm_naive<EpiSwiglu, true><<<(MT / 64) * (DFF / 64), 256, 0, stream>>>(HN2, WtGU, DM, DFF / 64, E); }
    { EpiResid E{X1, OUT}; k_gemm_naive<EpiResid, false><<<(MT / 64) * (DM / 64), 256, 0, stream>>>(H, WtDown, DFF, DM / 64, E); }
    k_rmsnorm_f32<<<MT / 4, 256, 0, stream>>>(OUT, g_fin);
}
```

```cpp
#include <hip/hip_runtime.h>
#include <cstdint>
#include <cstdio>

typedef unsigned short bf16_t;
typedef unsigned short f16_t;

constexpr int MT = 32768, DM = 1024, NIN = 8192, DFF = 2816, SEQ = 4096, NBATCH = 8;
constexpr float EPS = 1e-6f;
constexpr float HSCALE = 0.08838834764831845f;

constexpr size_t MiB = 1u << 20;
constexpr size_t WS_CTL = 0;
constexpr size_t CTL_BYTES = 1 * MiB;
constexpr size_t CTL_VST = 256 * 1024;
constexpr size_t WS_WIN = 1 * MiB;
constexpr size_t WS_WA = 17 * MiB;
constexpr size_t WS_WB = 19 * MiB;
constexpr size_t WS_WOUT = 21 * MiB;
constexpr size_t WS_WGU = 23 * MiB;
constexpr size_t WS_WDOWN = 34 * MiB;
constexpr size_t WS_WM = 40 * MiB;
constexpr size_t WS_LB = 40 * MiB + 512 * 1024;
constexpr size_t WS_XN = 64 * MiB;
constexpr size_t WS_U = 128 * MiB;
constexpr size_t WS_V = 192 * MiB;
constexpr size_t WS_I = 256 * MiB;
constexpr size_t WS_G = 320 * MiB;
constexpr size_t WS_GA = 384 * MiB;
constexpr size_t WS_GB = 448 * MiB;
constexpr size_t WS_AACT = WS_XN, WS_OACT = WS_U, WS_MG = WS_I, WS_HN2 = WS_G, WS_X1 = WS_GA;
constexpr size_t WS_H = 64 * MiB;
constexpr size_t WS_END = 512 * MiB;
constexpr size_t OUT_Q = 0, OUT_F = 64 * MiB;

__device__ __forceinline__ float bf2f(bf16_t b) { return __uint_as_float((unsigned)b << 16); }
__device__ __forceinline__ bf16_t f2bf(float f) { unsigned u = __float_as_uint(f); return (bf16_t)((u + 0x7fffu + ((u >> 16) & 1u)) >> 16); }
__device__ __forceinline__ f16_t f2h(float f) { _Float16 h = (_Float16)f; return __builtin_bit_cast(unsigned short, h); }
__device__ __forceinline__ float h2f(f16_t u) { return (float)__builtin_bit_cast(_Float16, u); }
__device__ __forceinline__ float sigmoidf_(float x) { return 1.f / (1.f + __expf(-x)); }
__device__ __forceinline__ float siluf_(float x) { return x / (1.f + __expf(-x)); }
__device__ __forceinline__ float gelu_tanh(float x) { const float u = 1.5957691216057308f * (x + 0.044715f * x * x * x); return x / (1.f + __expf(-u)); }

struct EpiIn {
    bf16_t *U, *V, *Q, *I, *G, *GA, *GB; f16_t* F; float* VST; const float* lb;
    static __device__ __forceinline__ void store8(bf16_t* p, const float (&r)[8]) {
        uint4 w; w.x = (unsigned)f2bf(r[0]) | ((unsigned)f2bf(r[1]) << 16); w.y = (unsigned)f2bf(r[2]) | ((unsigned)f2bf(r[3]) << 16);
        w.z = (unsigned)f2bf(r[4]) | ((unsigned)f2bf(r[5]) << 16); w.w = (unsigned)f2bf(r[6]) | ((unsigned)f2bf(r[7]) << 16);
        *(uint4*)p = w;
    }
    template <int SEG, bool ATOM> __device__ __forceinline__ void seg(int row, int c, const float (&v)[8], float& s, float& s2) const {
        const size_t o = (size_t)row * DM + c; float r[8];
        if constexpr (SEG == 0) {
#pragma unroll
            for (int j = 0; j < 8; ++j) r[j] = gelu_tanh(v[j]);
            store8(U + o, r);
        } else if constexpr (SEG == 1) {
            float a = 0.f, a2 = 0.f;
#pragma unroll
            for (int j = 0; j < 8; ++j) { r[j] = gelu_tanh(v[j]); a += r[j]; a2 += r[j] * r[j]; }
            store8(V + o, r);
            if constexpr (ATOM) { atomicAdd(VST + 2 * (size_t)row, a); atomicAdd(VST + 2 * (size_t)row + 1, a2); } else { s += a; s2 += a2; }
        } else if constexpr (SEG == 2) {
#pragma unroll
            for (int j = 0; j < 8; ++j) r[j] = v[j] * HSCALE;
            store8(Q + o, r);
        } else if constexpr (SEG == 3) {
            const float4 la = *(const float4*)(lb + c), lc = *(const float4*)(lb + c + 4); const float l[8] = {la.x, la.y, la.z, la.w, lc.x, lc.y, lc.z, lc.w};
            unsigned w[4];
#pragma unroll
            for (int j = 0; j < 8; j += 2) {
                const float f0 = l[j] + (1.f - l[j]) * sigmoidf_(v[j]), f1 = l[j + 1] + (1.f - l[j + 1]) * sigmoidf_(v[j + 1]);
                w[j >> 1] = (unsigned)f2h(__logf(f0)) | ((unsigned)f2h(__logf(f1)) << 16);
            }
            *(uint4*)(F + o) = make_uint4(w[0], w[1], w[2], w[3]);
        } else if constexpr (SEG == 4) {
            store8(I + o, v);
        } else if constexpr (SEG == 5) {
#pragma unroll
            for (int j = 0; j < 8; ++j) r[j] = siluf_(v[j]);
            store8(G + o, r);
        } else {
#pragma unroll
            for (int j = 0; j < 8; ++j) r[j] = sigmoidf_(v[j]);
            store8((SEG == 6 ? GA : GB) + o, r);
        }
    }
    __device__ __forceinline__ void operator()(int row, int col, const float (&v)[8]) const {
        float s = 0.f, s2 = 0.f; const int c = col & 1023;
        switch (col >> 10) { case 0: seg<0, true>(row, c, v, s, s2); break; case 1: seg<1, true>(row, c, v, s, s2); break; case 2: seg<2, true>(row, c, v, s, s2); break; case 3: seg<3, true>(row, c, v, s, s2); break;
            case 4: seg<4, true>(row, c, v, s, s2); break; case 5: seg<5, true>(row, c, v, s, s2); break; case 6: seg<6, true>(row, c, v, s, s2); break; default: seg<7, true>(row, c, v, s, s2); break; }
    }
};
struct EpiBranchA {
    const bf16_t* GA; float* T;
    __device__ __forceinline__ void operator()(int row, int col, const float (&v)[8]) const {
        const size_t o = (size_t)row * DM + col; const uint4 g = *(const uint4*)(GA + o); const unsigned gw[4] = {g.x, g.y, g.z, g.w};
        float r[8];
#pragma unroll
        for (int j = 0; j < 8; ++j) r[j] = bf2f((bf16_t)(gw[j >> 1] >> (16 * (j & 1)))) * v[j];
        *(float4*)(T + o) = make_float4(r[0], r[1], r[2], r[3]); *(float4*)(T + o + 4) = make_float4(r[4], r[5], r[6], r[7]);
    }
};
struct EpiBranchB {
    const bf16_t* GB; const float* T; bf16_t* MG;
    __device__ __forceinline__ void operator()(int row, int col, const float (&v)[8]) const {
        const size_t o = (size_t)row * DM + col; const uint4 g = *(const uint4*)(GB + o); const unsigned gw[4] = {g.x, g.y, g.z, g.w};
        const float4 t0 = *(const float4*)(T + o), t1 = *(const float4*)(T + o + 4); const float t[8] = {t0.x, t0.y, t0.z, t0.w, t1.x, t1.y, t1.z, t1.w};
        float r[8];
#pragma unroll
        for (int j = 0; j < 8; ++j) r[j] = t[j] + bf2f((bf16_t)(gw[j >> 1] >> (16 * (j & 1)))) * v[j];
        EpiIn::store8(MG + o, r);
    }
};
struct EpiResid {
    const float* BASE; float* OUT;
    __device__ __forceinline__ void operator()(int row, int col, const float (&v)[8]) const {
        const size_t o = (size_t)row * DM + col; const float4 b0 = *(const float4*)(BASE + o), b1 = *(const float4*)(BASE + o + 4);
        *(float4*)(OUT + o) = make_float4(b0.x + v[0], b0.y + v[1], b0.z + v[2], b0.w + v[3]);
        *(float4*)(OUT + o + 4) = make_float4(b1.x + v[4], b1.y + v[5], b1.z + v[6], b1.w + v[7]);
    }
};
struct EpiSwiglu {
    bf16_t* H;
    __device__ __forceinline__ void pair(int row, int col, const float (&g)[8], const float (&u)[8]) const {
        float r[8];
#pragma unroll
        for (int j = 0; j < 8; ++j) r[j] = siluf_(g[j]) * u[j];
        EpiIn::store8(H + (size_t)row * DFF + col, r);
    }
};

__global__ void k_transpose(const float* W, bf16_t* WT, int K, int N) {
    const size_t i = (size_t)blockIdx.x * blockDim.x + threadIdx.x; if (i >= (size_t)K * N) return;
    const int n = (int)(i / K), k = (int)(i % K); WT[i] = f2bf(W[(size_t)k * N + n]);
}
__global__ void k_transpose_gu(const float* W, bf16_t* WT) {
    const size_t i = (size_t)blockIdx.x * blockDim.x + threadIdx.x; if (i >= (size_t)2 * DFF * DM) return;
    const int r = (int)(i / DM), k = (int)(i % DM); const int j = r >> 8, w = r & 255; const int col = (w < 128) ? (j * 128 + w) : (DFF + j * 128 + (w - 128));
    WT[i] = f2bf(W[(size_t)k * (2 * DFF) + col]);
}
__global__ void k_small(const float* ws, const float* lbt, bf16_t* WM, float* LB) {
    const int i = blockIdx.x * blockDim.x + threadIdx.x;
    if (i < 8 * 128 * 128) { const int t = (i >> 7) & 127, s = i & 127; WM[i] = (s <= t) ? f2bf(ws[i]) : (bf16_t)0; }
    if (i < 1024) { const float a = lbt[i], b = lbt[1024 + i]; const float m = fmaxf(a, b); const float ea = __expf(a - m), eb = __expf(b - m); LB[i] = ea / (ea + eb); }
}
__global__ void __launch_bounds__(256) k_rmsnorm_bf16(const float* X, const float* g, bf16_t* O) {
    const int row = blockIdx.x * 4 + (threadIdx.x >> 6), lane = threadIdx.x & 63;
    const float4* xr = (const float4*)(X + (size_t)row * DM) + lane; float4 v[4]; float s = 0.f;
#pragma unroll
    for (int j = 0; j < 4; ++j) { v[j] = xr[64 * j]; s += v[j].x * v[j].x + v[j].y * v[j].y + v[j].z * v[j].z + v[j].w * v[j].w; }
#pragma unroll
    for (int o = 1; o < 64; o <<= 1) s += __shfl_xor(s, o);
    const float r = rsqrtf(s * (1.f / DM) + EPS);
#pragma unroll
    for (int j = 0; j < 4; ++j) { const float4 gg = ((const float4*)g)[lane + 64 * j];
        uint2 w; w.x = (unsigned)f2bf(v[j].x * r * gg.x) | ((unsigned)f2bf(v[j].y * r * gg.y) << 16); w.y = (unsigned)f2bf(v[j].z * r * gg.z) | ((unsigned)f2bf(v[j].w * r * gg.w) << 16);
        ((uint2*)(O + (size_t)row * DM))[lane + 64 * j] = w; }
}
__global__ void __launch_bounds__(256) k_rmsnorm_f32(float* X, const float* g) {
    const int row = blockIdx.x * 4 + (threadIdx.x >> 6), lane = threadIdx.x & 63;
    float4* xr = (float4*)(X + (size_t)row * DM) + lane; float4 v[4]; float s = 0.f;
#pragma unroll
    for (int j = 0; j < 4; ++j) { v[j] = xr[64 * j]; s += v[j].x * v[j].x + v[j].y * v[j].y + v[j].z * v[j].z + v[j].w * v[j].w; }
#pragma unroll
    for (int o = 1; o < 64; o <<= 1) s += __shfl_xor(s, o);
    const float r = rsqrtf(s * (1.f / DM) + EPS);
#pragma unroll
    for (int j = 0; j < 4; ++j) { const float4 gg = ((const float4*)g)[lane + 64 * j]; xr[64 * j] = make_float4(v[j].x * r * gg.x, v[j].y * r * gg.y, v[j].z * r * gg.z, v[j].w * r * gg.w); }
}

template <class Epi, bool DUAL>
__global__ void __launch_bounds__(256) k_gemm_naive(const bf16_t* A, const bf16_t* Bt, int K, int ntn, Epi E) {
    __shared__ float As[64][33], Bs[64][33], Bs2[DUAL ? 64 : 1][33];
    const int t = threadIdx.x, tr = t >> 3, tc = t & 7;
    const int tm = blockIdx.x / ntn, tn = blockIdx.x % ntn;
    const int row0 = tm * 64; int brow0, col0;
    if (DUAL) { col0 = tn * 64; brow0 = (col0 >> 7) * 256 + (col0 & 127); } else { col0 = tn * 64; brow0 = col0; }
    float acc[2][8], acc2[2][8];
#pragma unroll
    for (int i = 0; i < 2; ++i)
#pragma unroll
        for (int j = 0; j < 8; ++j) { acc[i][j] = 0.f; acc2[i][j] = 0.f; }
    const int lr = t >> 2, lk = (t & 3) * 8;
    for (int k0 = 0; k0 < K; k0 += 32) {
        { const uint4 a = *(const uint4*)(A + (size_t)(row0 + lr) * K + k0 + lk); const unsigned w[4] = {a.x, a.y, a.z, a.w};
#pragma unroll
          for (int j = 0; j < 8; ++j) As[lr][lk + j] = bf2f((bf16_t)(w[j >> 1] >> (16 * (j & 1)))); }
        { const uint4 a = *(const uint4*)(Bt + (size_t)(brow0 + lr) * K + k0 + lk); const unsigned w[4] = {a.x, a.y, a.z, a.w};
#pragma unroll
          for (int j = 0; j < 8; ++j) Bs[lr][lk + j] = bf2f((bf16_t)(w[j >> 1] >> (16 * (j & 1)))); }
        if (DUAL) { const uint4 a = *(const uint4*)(Bt + (size_t)(brow0 + 128 + lr) * K + k0 + lk); const unsigned w[4] = {a.x, a.y, a.z, a.w};
#pragma unroll
          for (int j = 0; j < 8; ++j) Bs2[lr][lk + j] = bf2f((bf16_t)(w[j >> 1] >> (16 * (j & 1)))); }
        __syncthreads();
#pragma unroll 8
        for (int k = 0; k < 32; ++k) {
            const float a0 = As[tr][k], a1 = As[tr + 32][k];
#pragma unroll
            for (int j = 0; j < 8; ++j) { const float b = Bs[tc * 8 + j][k]; acc[0][j] += a0 * b; acc[1][j] += a1 * b;
                if (DUAL) { const float b2 = Bs2[tc * 8 + j][k]; acc2[0][j] += a0 * b2; acc2[1][j] += a1 * b2; } }
        }
        __syncthreads();
    }
    if constexpr (DUAL) { E.pair(row0 + tr, col0 + tc * 8, acc[0], acc2[0]); E.pair(row0 + tr + 32, col0 + tc * 8, acc[1], acc2[1]); }
    else { E(row0 + tr, col0 + tc * 8, acc[0]); E(row0 + tr + 32, col0 + tc * 8, acc[1]); }
}

__global__ void __launch_bounds__(256) k_gmlp_naive(const bf16_t* U, const bf16_t* V, const float* VST, const bf16_t* WM, const float* lng, const float* lnb, const float* bs, bf16_t* AACT) {
    __shared__ float Vl[128][128];
    const int unit = blockIdx.x, g = unit & 7, n = (unit >> 3) & 31, b = unit >> 8; const int t = threadIdx.x;
    const size_t r0 = (size_t)b * SEQ + n * 128;
    for (int i = t; i < 128 * 128; i += 256) { const int s = i >> 7, d = i & 127; const size_t row = r0 + s;
        const float mu = VST[2 * row] * (1.f / DM), var = VST[2 * row + 1] * (1.f / DM) - mu * mu; const float rs = rsqrtf(var + EPS);
        Vl[s][d] = (bf2f(V[row * DM + g * 128 + d]) - mu) * rs * lng[g * 128 + d] + lnb[g * 128 + d]; }
    __syncthreads();
    const int d = t & 127, th = t >> 7;
    for (int tt = th * 64; tt < th * 64 + 64; ++tt) {
        float acc = 0.f; const bf16_t* wr = WM + ((size_t)g * 128 + tt) * 128;
        for (int s = 0; s <= tt; ++s) acc += bf2f(wr[s]) * Vl[s][d];
        const size_t o = (r0 + tt) * DM + g * 128 + d;
        AACT[o] = f2bf(bf2f(U[o]) * (acc + bs[g * 128 + tt]));
    }
}

__global__ void __launch_bounds__(128) k_hgrn_naive(const bf16_t* Q, const f16_t* F, const bf16_t* I, const bf16_t* G, const float* ng, bf16_t* OACT) {
    __shared__ float fS[2][128], kS[2][128], qS[2][128], part[2][2];
    const int b = blockIdx.x >> 3, h = blockIdx.x & 7, v = threadIdx.x, lane = v & 63, wv = v >> 6;
    float S[128];
#pragma unroll
    for (int k = 0; k < 128; ++k) S[k] = 0.f;
    const size_t base = (size_t)b * SEQ * DM + h * 128 + v;
    { const float lf = h2f(F[base]); fS[0][v] = __expf(lf); kS[0][v] = -expm1f(lf); qS[0][v] = bf2f(Q[base]); }
    __syncthreads();
    const float gn = ng[h * 128 + v];
    for (int t = 0; t < SEQ; ++t) {
        const int buf = t & 1; const size_t idx = base + (size_t)t * DM;
        if (t + 1 < SEQ) { const float lf = h2f(F[idx + DM]); fS[buf ^ 1][v] = __expf(lf); kS[buf ^ 1][v] = -expm1f(lf); qS[buf ^ 1][v] = bf2f(Q[idx + DM]); }
        const float iv = bf2f(I[idx]); float o = 0.f;
#pragma unroll
        for (int k = 0; k < 128; ++k) { S[k] = fS[buf][k] * S[k] + kS[buf][k] * iv; o += qS[buf][k] * S[k]; }
        float ss = o * o;
#pragma unroll
        for (int off = 1; off < 64; off <<= 1) ss += __shfl_xor(ss, off);
        if (lane == 0) part[buf][wv] = ss;
        __syncthreads();
        const float r = rsqrtf((part[buf][0] + part[buf][1]) * (1.f / 128.f) + EPS);
        OACT[idx] = f2bf(o * r * gn * bf2f(G[idx]));
    }
}

namespace pg8 {
#define PG8_LAS __attribute__((address_space(3)))
typedef short bf16x8 __attribute__((ext_vector_type(8)));
typedef float f32x4 __attribute__((ext_vector_type(4)));
typedef unsigned u32x4 __attribute__((ext_vector_type(4)));
constexpr int BM = 256, BK = 64, HALF = 128, HTB = HALF * BK * 2  , STAGE_BYTES = 8 * HTB, NXCD = 8, WGM = 8;

__host__ __device__ __forceinline__ int lds_byte(int r, int c) { const int st = (r >> 4) * 2 + (c >> 5), rr = r & 15, cc = c & 31, ob = rr * 64 + cc * 2; return st * 1024 + (ob ^ (((ob >> 9) & 1) << 5)); }
__host__ __device__ __forceinline__ void stage_rc(int b, int& R, int& C) { const int st = b / 1024, sb = b % 1024, swz = sb ^ (((sb >> 9) & 1) << 5); R = (st >> 1) * 16 + swz / 64; C = (st & 1) * 32 + (swz % 64) / 2; }
__host__ __device__ __forceinline__ int perm32(int rho) { const int n = rho >> 4, i = rho & 15; return 8 * (i >> 2) + 4 * n + (i & 3); }

struct Unit { int pm, pn, z; };
struct Gemm { const bf16_t* A; const bf16_t* Bt; const bf16_t* A2; const bf16_t* Bt2; int K; };

struct StaticOrder {
    int nM, nN, nwg, G, c;
    __host__ __device__ void init(int M, int N, int G_, int c_) { nM = M / BM; nN = N / BM; nwg = nM * nN; G = G_; c = c_; }
    __host__ __device__ bool next(int i, Unit& u) const {
        const long L = (long)i * G + c; if (L >= nwg) return false;
        int wgid = (int)L; { const int q = nwg / NXCD, r = nwg % NXCD, xcd = wgid % NXCD, off = wgid / NXCD; wgid = (xcd < r ? xcd * (q + 1) : r * (q + 1) + (xcd - r) * q) + off; }
        const int nig = WGM * nN, gid = wgid / nig, fm = gid * WGM, gsz = (nM - fm) < WGM ? (nM - fm) : WGM;
        u.pm = fm + ((wgid % nig) % gsz); u.pn = (wgid % nig) / gsz; u.z = 0; return true;
    }
};
struct PairedOrder : StaticOrder {
    __host__ __device__ bool next(int i, Unit& u) const { if (!StaticOrder::next(i >> 1, u)) return false; u.z = i & 1; return true; }
};

template <class Epi, class Sched, bool ALIGN_EPI = false, bool SP2 = false>
__device__ __forceinline__ void gemm_phase(PG8_LAS unsigned char* lds, const Gemm g, const Sched& S, const Epi& E) {
    const int tid = threadIdx.x, wid = __builtin_amdgcn_readfirstlane(tid >> 6), lane = tid & 63, wr = wid >> 2, wc = wid & 3, fr = lane & 15, fq = lane >> 4;
    const int K = g.K, nt = K / BK;
    unsigned voffA[2], voffB[2];
#pragma unroll
    for (int i = 0; i < 2; ++i) { int R, C; stage_rc(tid * 16 + i * 8192, R, C); const int Rb = Epi::PERM ? ((R & ~31) + perm32(R & 31)) : R;
        voffA[i] = (unsigned)(R * K + C) * 2u; voffB[i] = (unsigned)(Rb * K + C) * 2u; }
    const size_t kstep = (size_t)(BK * 2);
    const size_t hstep = (size_t)HALF * K * 2;
    const size_t tstep = 2 * hstep;
    const unsigned ldsw = (unsigned)wid * 1024u;
    const int aoff = lds_byte(wr * 64 + fr, fq * 8), boff = lds_byte(wc * 32 + fr, fq * 8);
#define PG8_SA(b, h) (((b) * 2 + (h)) * HTB)
#define PG8_SB(b, h) ((4 + (b) * 2 + (h)) * HTB)
#define PG8_STAGE(bufoff, gbase, voff) do { _Pragma("unroll") for (int _i = 0; _i < 2; ++_i) \
        __builtin_amdgcn_global_load_lds((const unsigned*)((const char*)(gbase) + (voff)[_i]), (PG8_LAS unsigned*)(lds + (bufoff) + ldsw + _i * 8192), 16, 0, 0); } while (0)
#define PG8_LDA(dst, b, h) do { _Pragma("unroll") for (int m = 0; m < 4; ++m) _Pragma("unroll") for (int k = 0; k < 2; ++k) dst[m][k] = *(const PG8_LAS bf16x8*)(lds + PG8_SA(b, h) + aoff + m * 2048 + k * 1024); } while (0)
#define PG8_LDB(dst, b, h) do { _Pragma("unroll") for (int n = 0; n < 2; ++n) _Pragma("unroll") for (int k = 0; k < 2; ++k) dst[n][k] = *(const PG8_LAS bf16x8*)(lds + PG8_SB(b, h) + boff + n * 2048 + k * 1024); } while (0)
#define PG8_MMA(ai, bj, At, Bt) do { __builtin_amdgcn_s_setprio(1); _Pragma("unroll") for (int m = 0; m < 4; ++m) _Pragma("unroll") for (int n = 0; n < 2; ++n) _Pragma("unroll") for (int k = 0; k < 2; ++k) \
        acc[ai][bj][m][n] = __builtin_amdgcn_mfma_f32_16x16x32_bf16(Bt[n][k], At[m][k], acc[ai][bj][m][n], 0, 0, 0); __builtin_amdgcn_s_setprio(0); } while (0)
#define PG8_WAIT_V(n) asm volatile("s_waitcnt vmcnt(" #n ")" ::: "memory")
#define PG8_WAIT_L(n) asm volatile("s_waitcnt lgkmcnt(" #n ")" ::: "memory")
#define PG8_BAR __builtin_amdgcn_s_barrier()
#define PG8_SCHED __builtin_amdgcn_sched_barrier(0)
#define PG8_ABASE(u) ((const char*)((u).z ? g.A2 : g.A) + (size_t)(u).pm * tstep)
#define PG8_BBASE(u) ((const char*)((u).z ? g.Bt2 : g.Bt) + (size_t)(u).pn * tstep)
    Unit cur, nxt; int ui = 0;
    if (!S.next(0, cur)) return;
    f32x4 acc[2][2][4][2];
#pragma unroll
    for (int a = 0; a < 2; ++a)
#pragma unroll
        for (int b = 0; b < 2; ++b)
#pragma unroll
            for (int m = 0; m < 4; ++m)
#pragma unroll
                for (int n = 0; n < 2; ++n) acc[a][b][m][n] = (f32x4){0.f, 0.f, 0.f, 0.f};
    bf16x8 At[4][2], B0[2][2], B1[2][2];
    const char* cA = PG8_ABASE(cur); const char* cB = PG8_BBASE(cur);
    if constexpr (SP2) {
        PG8_STAGE(PG8_SB(0, 0), cB, voffB); PG8_STAGE(PG8_SB(0, 1), cB + hstep, voffB); PG8_STAGE(PG8_SA(0, 0), cA, voffA); PG8_STAGE(PG8_SA(0, 1), cA + hstep, voffA);
        if (wr == 1) PG8_BAR;
        PG8_WAIT_V(2); PG8_BAR;
        PG8_STAGE(PG8_SB(1, 0), cB + kstep, voffB); PG8_STAGE(PG8_SA(1, 0), cA + kstep, voffA); PG8_STAGE(PG8_SB(1, 1), cB + hstep + kstep, voffB);
        PG8_WAIT_V(6); PG8_BAR;
    } else {
        PG8_STAGE(PG8_SB(0, 0), cB, voffB); PG8_STAGE(PG8_SA(0, 0), cA, voffA); PG8_STAGE(PG8_SB(0, 1), cB + hstep, voffB); PG8_STAGE(PG8_SA(0, 1), cA + hstep, voffA);
        if (wr == 1) PG8_BAR;
        PG8_WAIT_V(4); PG8_BAR;
        PG8_STAGE(PG8_SB(1, 0), cB + kstep, voffB); PG8_STAGE(PG8_SA(1, 0), cA + kstep, voffA); PG8_STAGE(PG8_SB(1, 1), cB + hstep + kstep, voffB);
        PG8_WAIT_V(6); PG8_BAR;
    }
    for (;;) {
        const bool has_next = S.next(ui + 1, nxt);
        const char* nA = has_next ? PG8_ABASE(nxt) : cA; const char* nB = has_next ? PG8_BBASE(nxt) : cB;
        for (int t = 0; t < nt; t += 2) {
            const bool last = (t == nt - 2);
            const char* a1 = cA + (size_t)(t + 1) * kstep;
            const char* a2 = last ? nA : cA + (size_t)(t + 2) * kstep; const char* b2 = last ? nB : cB + (size_t)(t + 2) * kstep;
            const char* a3 = a2 + kstep; const char* b3 = b2 + kstep;
            if constexpr (SP2) {
            PG8_LDB(B0, 0, 0); PG8_LDB(B1, 0, 1); PG8_SCHED; PG8_LDA(At, 0, 0); PG8_STAGE(PG8_SA(1, 1), a1 + hstep, voffA);
            PG8_WAIT_V(8); PG8_WAIT_L(0); PG8_BAR; PG8_MMA(0, 0, At, B0); PG8_MMA(0, 1, At, B1); PG8_BAR; PG8_SCHED;
            PG8_LDA(At, 0, 1); PG8_STAGE(PG8_SB(0, 0), b2, voffB); PG8_STAGE(PG8_SB(0, 1), b2 + hstep, voffB); PG8_STAGE(PG8_SA(0, 0), a2, voffA);
            PG8_WAIT_V(8); PG8_WAIT_L(0); PG8_BAR; PG8_MMA(1, 0, At, B0); PG8_MMA(1, 1, At, B1); PG8_BAR; PG8_SCHED;
            PG8_LDB(B0, 1, 0); PG8_LDB(B1, 1, 1); PG8_SCHED; PG8_LDA(At, 1, 0); PG8_STAGE(PG8_SA(0, 1), a2 + hstep, voffA);
            PG8_WAIT_V(8); PG8_WAIT_L(0); PG8_BAR; PG8_MMA(0, 0, At, B0); PG8_MMA(0, 1, At, B1); PG8_BAR; PG8_SCHED;
            PG8_LDA(At, 1, 1); PG8_STAGE(PG8_SB(1, 0), b3, voffB); PG8_STAGE(PG8_SB(1, 1), b3 + hstep, voffB); PG8_STAGE(PG8_SA(1, 0), a3, voffA);
            PG8_WAIT_V(8); PG8_WAIT_L(0); PG8_BAR; PG8_MMA(1, 0, At, B0); PG8_MMA(1, 1, At, B1); PG8_BAR; PG8_SCHED;
            } else {
            PG8_LDB(B0, 0, 0); PG8_SCHED; PG8_LDA(At, 0, 0); PG8_STAGE(PG8_SA(1, 1), a1 + hstep, voffA);
            PG8_WAIT_L(8); PG8_BAR; PG8_WAIT_L(0); PG8_MMA(0, 0, At, B0); PG8_BAR; PG8_SCHED;
            PG8_LDB(B1, 0, 1); PG8_STAGE(PG8_SB(0, 0), b2, voffB);
            PG8_BAR; PG8_WAIT_L(0); PG8_MMA(0, 1, At, B1); PG8_BAR;
            PG8_LDA(At, 0, 1); PG8_STAGE(PG8_SA(0, 0), a2, voffA);
            PG8_BAR; PG8_WAIT_L(0); PG8_MMA(1, 0, At, B0); PG8_BAR; PG8_SCHED;
            PG8_STAGE(PG8_SB(0, 1), b2 + hstep, voffB);
            PG8_WAIT_V(6); PG8_BAR; PG8_MMA(1, 1, At, B1); PG8_BAR;
            PG8_LDB(B0, 1, 0); PG8_SCHED; PG8_LDA(At, 1, 0); PG8_STAGE(PG8_SA(0, 1), a2 + hstep, voffA);
            PG8_WAIT_L(8); PG8_BAR; PG8_WAIT_L(0); PG8_MMA(0, 0, At, B0); PG8_BAR; PG8_SCHED;
            PG8_LDB(B1, 1, 1); PG8_STAGE(PG8_SB(1, 0), b3, voffB);
            PG8_BAR; PG8_WAIT_L(0); PG8_MMA(0, 1, At, B1); PG8_BAR;
            PG8_LDA(At, 1, 1); PG8_STAGE(PG8_SA(1, 0), a3, voffA);
            PG8_BAR; PG8_WAIT_L(0); PG8_MMA(1, 0, At, B0); PG8_BAR; PG8_SCHED;
            PG8_STAGE(PG8_SB(1, 1), b3 + hstep, voffB);
            PG8_WAIT_V(6); PG8_BAR; PG8_MMA(1, 1, At, B1); PG8_BAR;
            }
        }
        if constexpr (ALIGN_EPI) { if (wr == 0) PG8_BAR; }
        E(acc, cur, wr, wc, fr, fq);
        if (!has_next) break;
#pragma unroll
        for (int a = 0; a < 2; ++a)
#pragma unroll
            for (int b = 0; b < 2; ++b)
#pragma unroll
                for (int m = 0; m < 4; ++m)
#pragma unroll
                    for (int n = 0; n < 2; ++n) acc[a][b][m][n] = (f32x4){0.f, 0.f, 0.f, 0.f};
        cur = nxt; cA = nA; cB = nB; ++ui;
        if constexpr (ALIGN_EPI) { if (wr == 1) PG8_BAR; }
    }
    PG8_WAIT_V(0);
    if constexpr (!ALIGN_EPI) { if (wr == 0) PG8_BAR; }
    PG8_BAR;
#undef PG8_SA
#undef PG8_SB
#undef PG8_STAGE
#undef PG8_LDA
#undef PG8_LDB
#undef PG8_MMA
#undef PG8_WAIT_V
#undef PG8_WAIT_L
#undef PG8_BAR
#undef PG8_SCHED
#undef PG8_ABASE
#undef PG8_BBASE
}

template <class F> struct EpiRow8 {
    static constexpr bool PERM = true; F f;
    __device__ __forceinline__ void operator()(const f32x4 (&acc)[2][2][4][2], const Unit& u, int wr, int wc, int fr, int fq) const {
#pragma unroll
        for (int ai = 0; ai < 2; ++ai)
#pragma unroll
            for (int m = 0; m < 4; ++m) { const int row = u.pm * BM + ai * HALF + wr * 64 + m * 16 + fr;
#pragma unroll
                for (int bj = 0; bj < 2; ++bj) { const int col = u.pn * BM + bj * HALF + wc * 32 + 8 * fq;
                    const f32x4 a = acc[ai][bj][m][0], b = acc[ai][bj][m][1]; const float v[8] = {a[0], a[1], a[2], a[3], b[0], b[1], b[2], b[3]};
                    f(u.z, row, col, v); } }
    }
};
struct EpiPairSwiglu {
    static constexpr bool PERM = true; EpiSwiglu f;
    __device__ __forceinline__ void operator()(const f32x4 (&acc)[2][2][4][2], const Unit& u, int wr, int wc, int fr, int fq) const {
#pragma unroll
        for (int ai = 0; ai < 2; ++ai)
#pragma unroll
            for (int m = 0; m < 4; ++m) { const int row = u.pm * BM + ai * HALF + wr * 64 + m * 16 + fr; const int col = u.pn * HALF + wc * 32 + 8 * fq;
                const f32x4 a = acc[ai][0][m][0], b = acc[ai][0][m][1], c = acc[ai][1][m][0], d = acc[ai][1][m][1];
                const float gv[8] = {a[0], a[1], a[2], a[3], b[0], b[1], b[2], b[3]}, uv[8] = {c[0], c[1], c[2], c[3], d[0], d[1], d[2], d[3]};
                f.pair(row, col, gv, uv); }
    }
};
struct EpiInTile {
    static constexpr bool PERM = true; EpiIn e;
    template <int SEG> __device__ __forceinline__ void run(const f32x4 (&acc)[2][2][4][2], const Unit& u, int wr, int wc, int fr, int fq) const {
#pragma unroll
        for (int ai = 0; ai < 2; ++ai)
#pragma unroll
            for (int m = 0; m < 4; ++m) { const int row = u.pm * BM + ai * HALF + wr * 64 + m * 16 + fr; float s = 0.f, s2 = 0.f;
#pragma unroll
                for (int bj = 0; bj < 2; ++bj) { const int c = (u.pn & 3) * BM + bj * HALF + wc * 32 + 8 * fq;
                    const f32x4 a = acc[ai][bj][m][0], b = acc[ai][bj][m][1]; const float v[8] = {a[0], a[1], a[2], a[3], b[0], b[1], b[2], b[3]};
                    e.template seg<SEG, false>(row, c, v, s, s2); }
                if (SEG == 1) { s += __shfl_xor(s, 16); s += __shfl_xor(s, 32); s2 += __shfl_xor(s2, 16); s2 += __shfl_xor(s2, 32);
                    if (fq == 0) { atomicAdd(e.VST + 2 * (size_t)row, s); atomicAdd(e.VST + 2 * (size_t)row + 1, s2); } } }
    }
    __device__ __forceinline__ void operator()(const f32x4 (&acc)[2][2][4][2], const Unit& u, int wr, int wc, int fr, int fq) const {
        switch (u.pn >> 2) {
            case 0: run<0>(acc, u, wr, wc, fr, fq); break; case 1: run<1>(acc, u, wr, wc, fr, fq); break; case 2: run<2>(acc, u, wr, wc, fr, fq); break; case 3: run<3>(acc, u, wr, wc, fr, fq); break;
            case 4: run<4>(acc, u, wr, wc, fr, fq); break; case 5: run<5>(acc, u, wr, wc, fr, fq); break; case 6: run<6>(acc, u, wr, wc, fr, fq); break; default: run<7>(acc, u, wr, wc, fr, fq); break; }
    }
};
}

constexpr int NWAVES = 8;
constexpr int RING_BYTES = 131072, SCRATCH_BYTES = 139264, LDSCTL_OFF = SCRATCH_BYTES, MISC_OFF = LDSCTL_OFF + 320, LDS_BYTES = 147456;
constexpr int CW_BAR = 4096;
#define GAS __attribute__((address_space(1)))
#define LAS __attribute__((address_space(3)))
typedef GAS unsigned gu32;
#define RLX_AGENT __ATOMIC_RELAXED, __HIP_MEMORY_SCOPE_AGENT
#define LDS_WAIT() asm volatile("s_waitcnt lgkmcnt(0)" ::: "memory")
#define VM_WAIT() asm volatile("s_waitcnt vmcnt(0)" ::: "memory")

#define XB_TMO      128
#define XB_XCNT(j)  (256  + 64 * (j))
#define XB_XSUB(j)  (1280 + 64 * (j))
#define XB_XGEN(j)  (2304 + 64 * (j))
#define XB_TOP      3328
#define XB_TOPGEN   3392
#define XCD_BAR_WORDS 3456
#define XB_SPIN_CAP (1u << 18)
__device__ __forceinline__ unsigned xb_ld(unsigned* p)              { return __hip_atomic_load(p, __ATOMIC_RELAXED, __HIP_MEMORY_SCOPE_AGENT); }
__device__ __forceinline__ unsigned xb_add(unsigned* p, unsigned v) { return __hip_atomic_fetch_add(p, v, __ATOMIC_RELAXED, __HIP_MEMORY_SCOPE_AGENT); }
__device__ __forceinline__ unsigned xb_xcc_id() { return (unsigned)__builtin_amdgcn_s_getreg((3 << 11) | 20) & 0xFu; }
#define XB_SPIN(cond, bar) do { unsigned _sp = 0; while (cond) { __builtin_amdgcn_s_sleep(1); \
    if ((++_sp & 255u) == 0u) { if (xb_ld(&(bar)[XB_TMO])) break; if (_sp > XB_SPIN_CAP) { atomicAdd(&(bar)[XB_TMO], 1u); break; } } } } while (0)
struct XcdBarrier { unsigned* bar; unsigned x; volatile LAS unsigned* st; };
__device__ __forceinline__ XcdBarrier xcd_barrier_post(unsigned* bar, volatile LAS unsigned* st) {
    XcdBarrier b; b.bar = bar; b.x = xb_xcc_id(); b.st = st;
    if (threadIdx.x == 0) (void)xb_add(&bar[XB_XCNT(b.x)], 1u);
    return b;
}
__device__ __forceinline__ void xcd_barrier_complete(unsigned* bar, unsigned x, unsigned& nloc, unsigned& nx) {
    const unsigned G = gridDim.x * gridDim.y * gridDim.z;
    unsigned sum, cnt, mine, sp = 0u;
    for (;;) {
        sum = 0u; cnt = 0u; mine = 0u;
#pragma unroll
        for (unsigned j = 0; j < 16; ++j) { const unsigned c = xb_ld(&bar[XB_XCNT(j)]); sum += c; cnt += (c > 0u) ? 1u : 0u; mine = (j == x) ? c : mine; }
        if (sum == G) break;
        __builtin_amdgcn_s_sleep(1);
        if ((++sp & 255u) == 0u) { if (xb_ld(&bar[XB_TMO])) break; if (sp > XB_SPIN_CAP) { atomicAdd(&bar[XB_TMO], 1u); break; } }
    }
    nloc = mine > 0u ? mine : 1u; nx = cnt > 0u ? cnt : 1u;
}
__device__ __forceinline__ void xcd_barrier(const XcdBarrier& b) {
    asm volatile("s_waitcnt vmcnt(0)" ::: "memory");
    __syncthreads();
    if (threadIdx.x == 0) {
        unsigned* bar = b.bar;
        __builtin_amdgcn_s_waitcnt(0);
        unsigned nloc = b.st[0], nx = b.st[1];
        if (nloc == 0u) { xcd_barrier_complete(bar, b.x, nloc, nx); b.st[0] = nloc; b.st[1] = nx; }
        const unsigned old = xb_add(&bar[XB_XSUB(b.x)], 1u);
        const unsigned gen = old / nloc;
        if (old + 1u == (gen + 1u) * nloc) {
            __builtin_amdgcn_fence(__ATOMIC_RELEASE, "agent");
            asm volatile("s_waitcnt vmcnt(0)" ::: "memory");
            const unsigned og = xb_add(&bar[XB_TOP], 1u);
            const unsigned tg = og / nx;
            if (og + 1u == (tg + 1u) * nx) xb_add(&bar[XB_TOPGEN], 1u);
            else XB_SPIN(xb_ld(&bar[XB_TOPGEN]) == tg, bar);
            __builtin_amdgcn_fence(__ATOMIC_ACQUIRE, "agent");
            xb_add(&bar[XB_XGEN(b.x)], 1u);
            asm volatile("s_waitcnt vmcnt(0)" ::: "memory");
        } else {
            XB_SPIN(xb_ld(&bar[XB_XGEN(b.x)]) == gen, bar);
            __builtin_amdgcn_fence(__ATOMIC_ACQUIRE, "agent");
            asm volatile("s_waitcnt vmcnt(0)" ::: "memory");
        }
    }
    __syncthreads();
}

__device__ __forceinline__ unsigned pk2(float lo, float hi) { return (unsigned)f2bf(lo) | ((unsigned)f2bf(hi) << 16); }
typedef unsigned v4u __attribute__((ext_vector_type(4)));
__device__ __forceinline__ void p0_transpose_item(const float* Wc, int ldw, bf16_t* WTr, int K, int k0, LAS float* scr, int lane) {
#pragma unroll 8
    for (int i = 0; i < 32; ++i) { const int kk = 2 * i + (lane >> 5); scr[kk * 33 + (lane & 31)] = Wc[(size_t)(k0 + kk) * ldw + (lane & 31)]; }
    LDS_WAIT(); asm volatile("" ::: "memory");
    const int c = lane & 7;
#pragma unroll
    for (int j = 0; j < 4; ++j) { const int n = (lane >> 3) + 8 * j; const LAS float* s = scr + (8 * c) * 33 + n;
        v4u o; o.x = pk2(s[0 * 33], s[1 * 33]); o.y = pk2(s[2 * 33], s[3 * 33]); o.z = pk2(s[4 * 33], s[5 * 33]); o.w = pk2(s[6 * 33], s[7 * 33]);
        *(GAS v4u*)(WTr + (size_t)n * K + k0 + 8 * c) = o; }
    LDS_WAIT(); asm volatile("" ::: "memory");
}
__device__ __forceinline__ float wave_sum(float v) {
#pragma unroll
    for (int o = 1; o < 64; o <<= 1) v += __shfl_xor(v, o);
    return v;
}
__device__ __forceinline__ void rms_row_to_bf16(const float* xrow, const float* g, bf16_t* orow, int lane) {
    const float4* xr = (const float4*)xrow + lane; float4 v[4]; float s = 0.f;
#pragma unroll
    for (int j = 0; j < 4; ++j) { v[j] = xr[64 * j]; s += (v[j].x * v[j].x + v[j].y * v[j].y) + (v[j].z * v[j].z + v[j].w * v[j].w); }
    const float r = rsqrtf(wave_sum(s) * (1.f / DM) + EPS);
#pragma unroll
    for (int j = 0; j < 4; ++j) { const float4 gg = ((const float4*)g)[lane + 64 * j];
        uint2 w; w.x = pk2(v[j].x * r * gg.x, v[j].y * r * gg.y); w.y = pk2(v[j].z * r * gg.z, v[j].w * r * gg.w);
        ((uint2*)orow)[lane + 64 * j] = w; }
}


typedef short bf16x8_t __attribute__((ext_vector_type(8)));
typedef float f32x4_t __attribute__((ext_vector_type(4)));
constexpr int VT_STRIDE = 272;
constexpr int GMLP_UNITS = NBATCH * 32 * 8;
__device__ __forceinline__ void gmlp_unit(LAS unsigned char* lds, int unit, const bf16_t* U, const bf16_t* V, const float* VST, const bf16_t* WM, const float* lng, const float* lnb, const float* bs, bf16_t* AACT) {
    const int tid = threadIdx.x, lane = tid & 63, w = __builtin_amdgcn_readfirstlane(tid >> 6), fr = lane & 15, fq = lane >> 4;
    LAS float* sMu = (LAS float*)(lds + 36864); LAS float* sRs = sMu + 128;
    const int g = unit & 7, n = (unit >> 3) & 31, b = unit >> 8; const size_t r0 = (size_t)b * SEQ + n * 128;
    if (tid < 128) { const float2 st = *(const float2*)(VST + 2 * (r0 + tid)); const float mu = st.x * (1.f / DM), var = st.y * (1.f / DM) - mu * mu; sMu[tid] = mu; sRs[tid] = rsqrtf(var + EPS); }
    unsigned vv[2][8];
#pragma unroll
    for (int it = 0; it < 2; ++it)
#pragma unroll
        for (int j = 0; j < 8; ++j) vv[it][j] = *(const unsigned*)(V + (r0 + 8 * (w + 8 * it) + j) * DM + g * 128 + 2 * lane);
    const int nks = (w >> 1) + 1;
    bf16x8_t wf[4];
#pragma unroll
    for (int ks = 0; ks < 4; ++ks) { wf[ks] = (bf16x8_t){0, 0, 0, 0, 0, 0, 0, 0}; if (ks < nks) wf[ks] = *(const bf16x8_t*)(WM + ((size_t)(g * 128 + 16 * w + fr) * 128 + 32 * ks + 8 * fq)); }
    const float2 lg = *(const float2*)(lng + g * 128 + 2 * lane), lbv = *(const float2*)(lnb + g * 128 + 2 * lane);
    const int t = 16 * w + fr; const size_t orow = (r0 + t) * DM + g * 128 + 32 * fq;
    uint4 uu[4];
#pragma unroll
    for (int q = 0; q < 4; ++q) uu[q] = *(const uint4*)(U + orow + 8 * q);
    const float bias = bs[g * 128 + t];
    __syncthreads();
#pragma unroll
    for (int it = 0; it < 2; ++it) { const int sg = w + 8 * it; unsigned lo[4], hi[4];
#pragma unroll
        for (int j = 0; j < 8; j += 2) {
            const float m0 = sMu[8 * sg + j], r0s = sRs[8 * sg + j], m1 = sMu[8 * sg + j + 1], r1s = sRs[8 * sg + j + 1];
            const float a0 = (bf2f((bf16_t)(vv[it][j] & 0xffffu)) - m0) * r0s * lg.x + lbv.x, a1 = (bf2f((bf16_t)(vv[it][j + 1] & 0xffffu)) - m1) * r1s * lg.x + lbv.x;
            const float b0 = (bf2f((bf16_t)(vv[it][j] >> 16)) - m0) * r0s * lg.y + lbv.y, b1 = (bf2f((bf16_t)(vv[it][j + 1] >> 16)) - m1) * r1s * lg.y + lbv.y;
            lo[j >> 1] = pk2(a0, a1); hi[j >> 1] = pk2(b0, b1); }
        *(LAS v4u*)(lds + (2 * lane) * VT_STRIDE + 16 * sg) = (v4u){lo[0], lo[1], lo[2], lo[3]};
        *(LAS v4u*)(lds + (2 * lane + 1) * VT_STRIDE + 16 * sg) = (v4u){hi[0], hi[1], hi[2], hi[3]}; }
    __syncthreads();
    f32x4_t acc[8];
#pragma unroll
    for (int db = 0; db < 8; ++db) acc[db] = (f32x4_t){0.f, 0.f, 0.f, 0.f};
#pragma unroll
    for (int ks = 0; ks < 4; ++ks) if (ks < nks) {
#pragma unroll
        for (int db = 0; db < 8; ++db) { const bf16x8_t a = *(const LAS bf16x8_t*)(lds + (32 * (fr >> 2) + 4 * db + (fr & 3)) * VT_STRIDE + (32 * ks + 8 * fq) * 2);
            acc[db] = __builtin_amdgcn_mfma_f32_16x16x32_bf16(a, wf[ks], acc[db], 0, 0, 0); } }
#pragma unroll
    for (int q = 0; q < 4; ++q) { const unsigned uw[4] = {uu[q].x, uu[q].y, uu[q].z, uu[q].w}; unsigned o[4];
#pragma unroll
        for (int h = 0; h < 2; ++h) { const f32x4_t c = acc[2 * q + h];
            o[2 * h] = pk2(bf2f((bf16_t)(uw[2 * h] & 0xffffu)) * (c[0] + bias), bf2f((bf16_t)(uw[2 * h] >> 16)) * (c[1] + bias));
            o[2 * h + 1] = pk2(bf2f((bf16_t)(uw[2 * h + 1] & 0xffffu)) * (c[2] + bias), bf2f((bf16_t)(uw[2 * h + 1] >> 16)) * (c[3] + bias)); }
        *(uint4*)(AACT + orow + 8 * q) = make_uint4(o[0], o[1], o[2], o[3]); }
}

constexpr int NRUN = 4, RUNLEN = SEQ / NRUN, NCH = RUNLEN / 64;
constexpr int HG_RS = 272, HG_TS = 144;
constexpr int HG_QI = 0, HG_KI = 17408, HG_QD = 34816, HG_KDT = 52224, HG_IVT = 70656, HG_ST = 89088, HG_SC = 123904, HG_TOT = 133120, HG_SSQ = 137728;
static_assert(HG_SSQ + 512 <= SCRATCH_BYTES, "HGRN LDS map");
constexpr size_t WS_ET = 41 * MiB;
constexpr size_t WS_DR = 57 * MiB;
__device__ __forceinline__ f32x4_t mfma16(bf16x8_t a, bf16x8_t b, f32x4_t c) { return __builtin_amdgcn_mfma_f32_16x16x32_bf16(a, b, c, 0, 0, 0); }
typedef unsigned v2u __attribute__((ext_vector_type(2)));
typedef float f32x2_t __attribute__((ext_vector_type(2)));

template <bool PB>
__device__ __forceinline__ void hgrn_unit(LAS unsigned char* lds, int b, int h, int r, const bf16_t* Q, const f16_t* F, const bf16_t* I, const bf16_t* Gg, const float* ng, float* ET, float* DR, bf16_t* OACT) {
    const int tid = threadIdx.x, lane = tid & 63, w = __builtin_amdgcn_readfirstlane(tid >> 6), fr = lane & 15, fq = lane >> 4;
    const size_t R0 = (size_t)b * SEQ + (size_t)r * RUNLEN; const int C0 = h * 128; const int uidx = (b * 8 + h) * NRUN + r;
    LAS float* TOT = (LAS float*)(lds + HG_TOT); LAS float* DEC = TOT + 8 * 128; LAS float* SSQ = (LAS float*)(lds + HG_SSQ);
    f32x4_t st[8];
#pragma unroll
    for (int kb = 0; kb < 8; ++kb) st[kb] = (f32x4_t){0.f, 0.f, 0.f, 0.f};
    if constexpr (PB) {
        for (int rp = 0; rp < r; ++rp) { const int up = uidx - r + rp;
#pragma unroll
            for (int kb = 0; kb < 8; ++kb) { const f32x4_t d = *(const f32x4_t*)(DR + (size_t)up * 128 + 16 * kb + 4 * fq); const f32x4_t e = *(const f32x4_t*)(ET + ((size_t)up * 128 + 16 * w + fr) * 128 + 16 * kb + 4 * fq); st[kb] = d * st[kb] + e; } }
#pragma unroll
        for (int kb = 0; kb < 8; ++kb) *(LAS v2u*)(lds + HG_ST + (16 * w + fr) * HG_RS + (16 * kb + 4 * fq) * 2) = (v2u){pk2(st[kb][0], st[kb][1]), pk2(st[kb][2], st[kb][3])};
        for (int i = tid; i < 64 * HG_TS / 4; i += NWAVES * 64) ((LAS unsigned*)(lds + HG_SC))[i] = 0u;
    }
    float dlog0 = 0.f, dlog1 = 0.f;
    unsigned lfp[8], qp[8], ivp[8];
    const size_t lbase = C0 + 2 * lane;
#pragma unroll
    for (int j = 0; j < 8; ++j) { const size_t o = (R0 + 8 * w + j) * DM + lbase; lfp[j] = *(const unsigned*)(F + o); ivp[j] = *(const unsigned*)(I + o); if (PB) qp[j] = *(const unsigned*)(Q + o); }
    for (int c = 0; c < NCH; ++c) {
        const size_t Rc = R0 + 64 * c;
        float lf0[8], lf1[8], A0[8], A1[8];
#pragma unroll
        for (int j = 0; j < 8; ++j) { lf0[j] = h2f((f16_t)(lfp[j] & 0xffffu)); lf1[j] = h2f((f16_t)(lfp[j] >> 16)); }
        A0[0] = lf0[0]; A1[0] = lf1[0];
#pragma unroll
        for (int j = 1; j < 8; ++j) { A0[j] = A0[j - 1] + lf0[j]; A1[j] = A1[j - 1] + lf1[j]; }
        *(LAS f32x2_t*)(TOT + w * 128 + 2 * lane) = (f32x2_t){A0[7], A1[7]};
        __syncthreads();
        float off0 = 0.f, off1 = 0.f, am0 = 0.f, am1 = 0.f, al0 = 0.f, al1 = 0.f;
#pragma unroll
        for (int w2 = 0; w2 < 8; ++w2) { const f32x2_t t = *(const LAS f32x2_t*)(TOT + w2 * 128 + 2 * lane); if (w2 < w) { off0 += t.x; off1 += t.y; } if (w2 < 4) { am0 += t.x; am1 += t.y; } al0 += t.x; al1 += t.y; }
        if (w == 0) *(LAS f32x2_t*)(DEC + 2 * lane) = (f32x2_t){__expf(al0), __expf(al1)};
        dlog0 += al0; dlog1 += al1;
        if constexpr (PB) {
            const float eam0 = __expf(am0), eam1 = __expf(am1), elm0 = __expf(al0 - am0), elm1 = __expf(al1 - am1);
            unsigned kd0[4], kd1[4]; float kdp0 = 0.f, kdp1 = 0.f;
#pragma unroll
            for (int j = 0; j < 8; ++j) {
                const float a0 = off0 + A0[j], a1 = off1 + A1[j];
                const float d0 = fminf(fmaxf(a0 - am0, -80.f), 80.f), d1 = fminf(fmaxf(a1 - am1, -80.f), 80.f);
                const float e0 = __expf(d0), e1 = __expf(d1); const float r0 = __builtin_amdgcn_rcpf(e0), r1 = __builtin_amdgcn_rcpf(e1);
                const float k0 = 1.f - __expf(lf0[j]), k1 = 1.f - __expf(lf1[j]);
                const float q0 = bf2f((bf16_t)(qp[j] & 0xffffu)), q1 = bf2f((bf16_t)(qp[j] >> 16));
                const float qi0 = q0 * e0, qi1 = q1 * e1, ki0 = k0 * r0, ki1 = k1 * r1;
                const int t = 8 * w + j;
                *(LAS unsigned*)(lds + HG_QI + t * HG_RS + 4 * lane) = pk2(qi0, qi1);
                *(LAS unsigned*)(lds + HG_KI + t * HG_RS + 4 * lane) = pk2(ki0, ki1);
                *(LAS unsigned*)(lds + HG_QD + t * HG_RS + 4 * lane) = pk2(qi0 * eam0, qi1 * eam1);
                const float x0 = ki0 * elm0, x1 = ki1 * elm1;
                if (j & 1) { kd0[j >> 1] = pk2(kdp0, x0); kd1[j >> 1] = pk2(kdp1, x1); } else { kdp0 = x0; kdp1 = x1; }
            }
            *(LAS v4u*)(lds + HG_KDT + (2 * lane) * HG_TS + 16 * w) = (v4u){kd0[0], kd0[1], kd0[2], kd0[3]};
            *(LAS v4u*)(lds + HG_KDT + (2 * lane + 1) * HG_TS + 16 * w) = (v4u){kd1[0], kd1[1], kd1[2], kd1[3]};
        } else {
            unsigned kd0[4], kd1[4]; float kdp0 = 0.f, kdp1 = 0.f;
#pragma unroll
            for (int j = 0; j < 8; ++j) {
                const float a0 = off0 + A0[j], a1 = off1 + A1[j];
                const float x0 = (1.f - __expf(lf0[j])) * __expf(al0 - a0), x1 = (1.f - __expf(lf1[j])) * __expf(al1 - a1);
                if (j & 1) { kd0[j >> 1] = pk2(kdp0, x0); kd1[j >> 1] = pk2(kdp1, x1); } else { kdp0 = x0; kdp1 = x1; }
            }
            *(LAS v4u*)(lds + HG_KDT + (2 * lane) * HG_TS + 16 * w) = (v4u){kd0[0], kd0[1], kd0[2], kd0[3]};
            *(LAS v4u*)(lds + HG_KDT + (2 * lane + 1) * HG_TS + 16 * w) = (v4u){kd1[0], kd1[1], kd1[2], kd1[3]};
        }
        *(LAS v4u*)(lds + HG_IVT + (2 * lane) * HG_TS + 16 * w) = (v4u){(ivp[0] & 0xffffu) | (ivp[1] << 16), (ivp[2] & 0xffffu) | (ivp[3] << 16), (ivp[4] & 0xffffu) | (ivp[5] << 16), (ivp[6] & 0xffffu) | (ivp[7] << 16)};
        *(LAS v4u*)(lds + HG_IVT + (2 * lane + 1) * HG_TS + 16 * w) = (v4u){(ivp[0] >> 16) | (ivp[1] & 0xffff0000u), (ivp[2] >> 16) | (ivp[3] & 0xffff0000u), (ivp[4] >> 16) | (ivp[5] & 0xffff0000u), (ivp[6] >> 16) | (ivp[7] & 0xffff0000u)};
        if (c + 1 < NCH) {
#pragma unroll
            for (int j = 0; j < 8; ++j) { const size_t o = (Rc + 64 + 8 * w + j) * DM + lbase; lfp[j] = *(const unsigned*)(F + o); ivp[j] = *(const unsigned*)(I + o); if (PB) qp[j] = *(const unsigned*)(Q + o); }
        }
        const int tb = w & 3, vh = w >> 2;
        uint4 gg[2]; size_t oo = 0;
        if constexpr (PB) { oo = (Rc + 16 * tb + fr) * DM + C0 + 64 * vh + 16 * fq; gg[0] = *(const uint4*)(Gg + oo); gg[1] = *(const uint4*)(Gg + oo + 8); }
        __syncthreads();
        if constexpr (PB) {
            for (int ti = w; ti < 10; ti += 8) {
                const int tb2 = (ti >= 6) ? 3 : (ti >= 3) ? 2 : (ti >= 1) ? 1 : 0, sb = ti - (tb2 * (tb2 + 1)) / 2;
                f32x4_t sc = (f32x4_t){0.f, 0.f, 0.f, 0.f};
#pragma unroll
                for (int ks = 0; ks < 4; ++ks) { const bf16x8_t a = *(const LAS bf16x8_t*)(lds + HG_KI + (16 * sb + fr) * HG_RS + (32 * ks + 8 * fq) * 2); const bf16x8_t bq = *(const LAS bf16x8_t*)(lds + HG_QI + (16 * tb2 + fr) * HG_RS + (32 * ks + 8 * fq) * 2); sc = mfma16(a, bq, sc); }
                const int tt = 16 * tb2 + fr, s0 = 16 * sb + 4 * fq;
                const float v0 = (s0 <= tt) ? sc[0] : 0.f, v1 = (s0 + 1 <= tt) ? sc[1] : 0.f, v2 = (s0 + 2 <= tt) ? sc[2] : 0.f, v3 = (s0 + 3 <= tt) ? sc[3] : 0.f;
                *(LAS v2u*)(lds + HG_SC + tt * HG_TS + s0 * 2) = (v2u){pk2(v0, v1), pk2(v2, v3)};
            }
        }
#pragma unroll
        for (int kb = 0; kb < 8; ++kb) { const f32x4_t dv = *(const LAS f32x4_t*)(DEC + 16 * kb + 4 * fq); st[kb] = st[kb] * dv; }
#pragma unroll
        for (int ks = 0; ks < 2; ++ks) { const bf16x8_t bi = *(const LAS bf16x8_t*)(lds + HG_IVT + (16 * w + fr) * HG_TS + (32 * ks + 8 * fq) * 2);
#pragma unroll
            for (int kb = 0; kb < 8; ++kb) { const bf16x8_t a = *(const LAS bf16x8_t*)(lds + HG_KDT + (16 * kb + fr) * HG_TS + (32 * ks + 8 * fq) * 2); st[kb] = mfma16(a, bi, st[kb]); } }
        if constexpr (PB) {
            __syncthreads();
            f32x4_t o[4];
#pragma unroll
            for (int x = 0; x < 4; ++x) { o[x] = (f32x4_t){0.f, 0.f, 0.f, 0.f}; const int vrow = 64 * vh + 16 * (fr >> 2) + 4 * x + (fr & 3);
#pragma unroll
                for (int ks = 0; ks < 2; ++ks) if (32 * ks <= 16 * tb + 15) { const bf16x8_t a = *(const LAS bf16x8_t*)(lds + HG_IVT + vrow * HG_TS + (32 * ks + 8 * fq) * 2); const bf16x8_t bs = *(const LAS bf16x8_t*)(lds + HG_SC + (16 * tb + fr) * HG_TS + (32 * ks + 8 * fq) * 2); o[x] = mfma16(a, bs, o[x]); }
#pragma unroll
                for (int ks = 0; ks < 4; ++ks) { const bf16x8_t a = *(const LAS bf16x8_t*)(lds + HG_ST + vrow * HG_RS + (32 * ks + 8 * fq) * 2); const bf16x8_t bq = *(const LAS bf16x8_t*)(lds + HG_QD + (16 * tb + fr) * HG_RS + (32 * ks + 8 * fq) * 2); o[x] = mfma16(a, bq, o[x]); } }
            float ss = 0.f;
#pragma unroll
            for (int x = 0; x < 4; ++x) ss += (o[x][0] * o[x][0] + o[x][1] * o[x][1]) + (o[x][2] * o[x][2] + o[x][3] * o[x][3]);
            ss += __shfl_xor(ss, 16); ss += __shfl_xor(ss, 32);
            if (fq == 0) SSQ[vh * 64 + 16 * tb + fr] = ss;
            __syncthreads();
            const float rn = rsqrtf((SSQ[16 * tb + fr] + SSQ[64 + 16 * tb + fr]) * (1.f / 128.f) + EPS);
            const float* ngp = ng + C0 + 64 * vh + 16 * fq; unsigned ow[8];
#pragma unroll
            for (int x = 0; x < 4; ++x) { const f32x4_t gn = *(const f32x4_t*)(ngp + 4 * x); const unsigned g0 = (x & 1) ? (x == 1 ? gg[0].z : gg[1].z) : (x == 0 ? gg[0].x : gg[1].x), g1 = (x & 1) ? (x == 1 ? gg[0].w : gg[1].w) : (x == 0 ? gg[0].y : gg[1].y);
                ow[2 * x] = pk2(o[x][0] * rn * gn[0] * bf2f((bf16_t)(g0 & 0xffffu)), o[x][1] * rn * gn[1] * bf2f((bf16_t)(g0 >> 16)));
                ow[2 * x + 1] = pk2(o[x][2] * rn * gn[2] * bf2f((bf16_t)(g1 & 0xffffu)), o[x][3] * rn * gn[3] * bf2f((bf16_t)(g1 >> 16))); }
            *(uint4*)(OACT + oo) = make_uint4(ow[0], ow[1], ow[2], ow[3]); *(uint4*)(OACT + oo + 8) = make_uint4(ow[4], ow[5], ow[6], ow[7]);
#pragma unroll
            for (int kb = 0; kb < 8; ++kb) *(LAS v2u*)(lds + HG_ST + (16 * w + fr) * HG_RS + (16 * kb + 4 * fq) * 2) = (v2u){pk2(st[kb][0], st[kb][1]), pk2(st[kb][2], st[kb][3])};
        }
    }
    if constexpr (!PB) {
#pragma unroll
        for (int kb = 0; kb < 8; ++kb) *(f32x4_t*)(ET + ((size_t)uidx * 128 + 16 * w + fr) * 128 + 16 * kb + 4 * fq) = st[kb];
        if (w == 0) *(f32x2_t*)(DR + (size_t)uidx * 128 + 2 * lane) = (f32x2_t){__expf(dlog0), __expf(dlog1)};
    }
    __syncthreads();
}

struct EpiBranch {
    EpiBranchA a; EpiBranchB b;
    __device__ __forceinline__ void operator()(int z, int row, int col, const float (&v)[8]) const { if (z == 0) a(row, col, v); else b(row, col, v); }
};
struct EpiResidZ { EpiResid e; __device__ __forceinline__ void operator()(int, int row, int col, const float (&v)[8]) const { e(row, col, v); } };

struct Args { const float* in[16]; float* out; unsigned char* ws; int ph_lo, ph_hi, li, pad; };

__global__ void __launch_bounds__(NWAVES * 64, 2) mega(Args args) {
    extern __shared__ __attribute__((aligned(16))) unsigned char lds_raw[];
    LAS unsigned char* lds = (LAS unsigned char*)lds_raw;
    volatile LAS unsigned* MISC = (volatile LAS unsigned*)(lds + MISC_OFF);
    const int tid = threadIdx.x, lane = tid & 63, wave = __builtin_amdgcn_readfirstlane(tid >> 6);
    const int G = gridDim.x, bx = blockIdx.x; const int vcu = (G % 8 == 0) ? (bx % 8) * (G / 8) + bx / 8 : bx;
    unsigned char* ws = args.ws; unsigned char* ob = (unsigned char*)args.out;
    for (int u = tid; u < (LDS_BYTES - LDSCTL_OFF) / 4; u += NWAVES * 64) ((LAS unsigned*)(lds + LDSCTL_OFF))[u] = 0u;
    __syncthreads();
    XcdBarrier bar = xcd_barrier_post((unsigned*)(ws + WS_CTL) + CW_BAR + args.li * XCD_BAR_WORDS, MISC + 8);
    const int lo = args.ph_lo, hi = args.ph_hi;
#define IN(k) (lo <= (k) && (k) < hi)
#define BOTH(k) (IN(k) && IN((k) + 1))
    const float* x = args.in[0];
    bf16_t *WtIn = (bf16_t*)(ws + WS_WIN), *WtA = (bf16_t*)(ws + WS_WA), *WtB = (bf16_t*)(ws + WS_WB), *WtOut = (bf16_t*)(ws + WS_WOUT), *WtGU = (bf16_t*)(ws + WS_WGU), *WtDown = (bf16_t*)(ws + WS_WDOWN), *WM = (bf16_t*)(ws + WS_WM);
    float* LB = (float*)(ws + WS_LB); float* VST = (float*)(ws + WS_CTL + CTL_VST);
    bf16_t *XN = (bf16_t*)(ws + WS_XN), *U = (bf16_t*)(ws + WS_U), *V = (bf16_t*)(ws + WS_V), *I = (bf16_t*)(ws + WS_I), *Gg = (bf16_t*)(ws + WS_G), *GA = (bf16_t*)(ws + WS_GA), *GB = (bf16_t*)(ws + WS_GB);
    bf16_t *Q = (bf16_t*)(ob + OUT_Q); f16_t* F = (f16_t*)(ob + OUT_F); float* T = (float*)args.out;
    bf16_t *AACT = (bf16_t*)(ws + WS_AACT), *OACT = (bf16_t*)(ws + WS_OACT), *MG = (bf16_t*)(ws + WS_MG), *HN2 = (bf16_t*)(ws + WS_HN2), *H = (bf16_t*)(ws + WS_H);
    float* X1 = (float*)(ws + WS_X1); float* OUT = args.out;

    if (IN(0)) {
        LAS float* scr = (LAS float*)(lds + wave * 16384);
        const int gw = vcu * NWAVES + wave, NGW = G * NWAVES;
        constexpr int I_IN = (DM / 64) * (NIN / 32), I_SQ = (DM / 64) * (DM / 32), I_GU = (DM / 64) * (2 * DFF / 32), I_DN = (DFF / 64) * (DM / 32);
        constexpr int NITEMS = I_IN + 3 * I_SQ + I_GU + I_DN;
        for (int it = gw; it < NITEMS; it += NGW) {
            int r = it;
            if (r < I_IN) { const int nb = r % (NIN / 32), kb = r / (NIN / 32); p0_transpose_item(args.in[2] + nb * 32, NIN, WtIn + (size_t)nb * 32 * DM, DM, kb * 64, scr, lane); continue; } r -= I_IN;
            if (r < 3 * I_SQ) { const int w = r / I_SQ; r -= w * I_SQ; const int nb = r % (DM / 32), kb = r / (DM / 32);
                const float* src = w == 0 ? args.in[9] : (w == 1 ? args.in[10] : args.in[11]); bf16_t* dst = w == 0 ? WtA : (w == 1 ? WtB : WtOut);
                p0_transpose_item(src + nb * 32, DM, dst + (size_t)nb * 32 * DM, DM, kb * 64, scr, lane); continue; } r -= 3 * I_SQ;
            if (r < I_GU) { const int nb = r % (2 * DFF / 32), kb = r / (2 * DFF / 32); const int r0 = nb * 32, j = r0 >> 8, w = r0 & 255; const int c0 = (w < 128) ? (j * 128 + w) : (DFF + j * 128 + (w - 128));
                p0_transpose_item(args.in[13] + c0, 2 * DFF, WtGU + (size_t)r0 * DM, DM, kb * 64, scr, lane); continue; } r -= I_GU;
            { const int nb = r % (DM / 32), kb = r / (DM / 32); p0_transpose_item(args.in[14] + nb * 32, DM, WtDown + (size_t)nb * 32 * DFF, DFF, kb * 64, scr, lane); }
        }
        for (int i = gw * 64 + lane; i < 8 * 128 * 128; i += NGW * 64) { const int t = (i >> 7) & 127, s = i & 127; WM[i] = (s <= t) ? f2bf(args.in[5][i]) : (bf16_t)0; }
        for (int i = gw * 64 + lane; i < 1024; i += NGW * 64) { const float a = args.in[7][i], b = args.in[7][1024 + i]; const float m = fmaxf(a, b); const float ea = __expf(a - m), eb = __expf(b - m); LB[i] = ea / (ea + eb); }
        for (int m = gw; m < MT; m += NGW) rms_row_to_bf16(x + (size_t)m * DM, args.in[1], XN + (size_t)m * DM, lane);
        if (BOTH(0)) xcd_barrier(bar);
    }
    if (IN(1)) {
        pg8::Gemm g{XN, WtIn, nullptr, nullptr, DM}; pg8::StaticOrder S; S.init(MT, NIN, G, bx);
        pg8::EpiInTile E{EpiIn{U, V, Q, I, Gg, GA, GB, F, VST, LB}};
        pg8::gemm_phase<pg8::EpiInTile, pg8::StaticOrder, true, true>(lds, g, S, E);
        if (BOTH(1)) xcd_barrier(bar);
    }
    if (IN(2)) {
        float* ET = (float*)(ws + WS_ET); float* DR = (float*)(ws + WS_DR);
        if (G == 256) {
            if (bx < 192) { hgrn_unit<false>(lds, bx / 24, (bx / 3) & 7, bx % 3, Q, F, I, Gg, args.in[8], ET, DR, OACT);
                for (int i = 0; i < 6; ++i) gmlp_unit(lds, 6 * bx + i, U, V, VST, WM, args.in[3], args.in[4], args.in[6], AACT); }
            else for (int i = 0; i < 14; ++i) gmlp_unit(lds, 1152 + 14 * (bx - 192) + i, U, V, VST, WM, args.in[3], args.in[4], args.in[6], AACT);
        } else {
            for (int u = bx; u < 192; u += G) hgrn_unit<false>(lds, u / 24, (u / 3) & 7, u % 3, Q, F, I, Gg, args.in[8], ET, DR, OACT);
            for (int unit = bx; unit < GMLP_UNITS; unit += G) gmlp_unit(lds, unit, U, V, VST, WM, args.in[3], args.in[4], args.in[6], AACT);
        }
        __syncthreads();
        if (BOTH(2)) xcd_barrier(bar);
    }
    if (IN(3)) {
        float* ET = (float*)(ws + WS_ET); float* DR = (float*)(ws + WS_DR);
        for (int u = bx; u < 64 * NRUN; u += G) hgrn_unit<true>(lds, u >> 5, (u >> 2) & 7, u & 3, Q, F, I, Gg, args.in[8], ET, DR, OACT);
        if (BOTH(3)) xcd_barrier(bar);
    }
    if (IN(4)) {
        pg8::Gemm g{AACT, WtA, OACT, WtB, DM}; pg8::PairedOrder S; S.init(MT, DM, G, bx);
        pg8::EpiRow8<EpiBranch> E{EpiBranch{EpiBranchA{GA, T}, EpiBranchB{GB, T, MG}}};
        pg8::gemm_phase<pg8::EpiRow8<EpiBranch>, pg8::PairedOrder, true, true>(lds, g, S, E);
        if (BOTH(4)) xcd_barrier(bar);
    }
    if (IN(5)) {
        pg8::Gemm g{MG, WtOut, nullptr, nullptr, DM}; pg8::StaticOrder S; S.init(MT, DM, G, bx);
        pg8::EpiRow8<EpiResidZ> E{EpiResidZ{EpiResid{x, X1}}};
        pg8::gemm_phase<pg8::EpiRow8<EpiResidZ>, pg8::StaticOrder, true, true>(lds, g, S, E);
        if (BOTH(5)) xcd_barrier(bar);
    }
    if (IN(6)) {
        const int gw = vcu * NWAVES + wave, NGW = G * NWAVES;
        for (int m = gw; m < MT; m += NGW) rms_row_to_bf16(X1 + (size_t)m * DM, args.in[12], HN2 + (size_t)m * DM, lane);
        if (BOTH(6)) xcd_barrier(bar);
    }
    if (IN(7)) {
        pg8::Gemm g{HN2, WtGU, nullptr, nullptr, DM}; pg8::StaticOrder S; S.init(MT, 2 * DFF, G, bx);
        pg8::EpiPairSwiglu E{EpiSwiglu{H}};
        pg8::gemm_phase<pg8::EpiPairSwiglu, pg8::StaticOrder, true, true>(lds, g, S, E);
        if (BOTH(7)) xcd_barrier(bar);
    }
    if (IN(8)) {
        pg8::Gemm g{H, WtDown, nullptr, nullptr, DFF}; pg8::StaticOrder S; S.init(MT, DM, G, bx);
        pg8::EpiRow8<EpiResidZ> E{EpiResidZ{EpiResid{X1, OUT}}};
        pg8::gemm_phase<pg8::EpiRow8<EpiResidZ>, pg8::StaticOrder, true, true>(lds, g, S, E);
        if (BOTH(8)) xcd_barrier(bar);
    }
    if (IN(9)) {
        const int gw = vcu * NWAVES + wave, NGW = G * NWAVES;
        for (int m = gw; m < MT; m += NGW) { float4* xr = (float4*)(OUT + (size_t)m * DM) + lane; float4 v[4]; float s = 0.f;
#pragma unroll
            for (int j = 0; j < 4; ++j) { v[j] = xr[64 * j]; s += (v[j].x * v[j].x + v[j].y * v[j].y) + (v[j].z * v[j].z + v[j].w * v[j].w); }
            const float r = rsqrtf(wave_sum(s) * (1.f / DM) + EPS);
#pragma unroll
            for (int j = 0; j < 4; ++j) { const float4 gg = ((const float4*)args.in[15])[lane + 64 * j]; xr[64 * j] = make_float4(v[j].x * r * gg.x, v[j].y * r * gg.y, v[j].z * r * gg.z, v[j].w * r * gg.w); } }
    }
#undef IN
#undef BOTH
}

static void launch_mega(const Args& base, int lo, int hi, int li, int grid, hipStream_t stream) {
    Args a = base; a.ph_lo = lo; a.ph_hi = hi; a.li = li; a.pad = 0;
    hipLaunchKernelGGL(mega, dim3(grid), dim3(NWAVES * 64), LDS_BYTES, stream, a);
}
extern "C" void kernel_launch(void* const* d_in, const int* in_sizes, int n_in, void* d_out, int out_size, void* d_ws, size_t ws_size, hipStream_t stream) {
    static int grid = 0;
    if (grid == 0) {
        if (n_in != 16 || in_sizes[0] != MT * DM || in_sizes[2] != DM * NIN || out_size != MT * DM || ws_size < WS_END) {
            fprintf(stderr, "kernel_launch: unexpected shapes (n_in %d, in0 %d, in2 %d, out %d, ws %zu)\n", n_in, n_in > 0 ? in_sizes[0] : -1, n_in > 2 ? in_sizes[2] : -1, out_size, ws_size); grid = -1; return; }
        int dev = 0, cus = 0, per_cu = 0;
        if (hipGetDevice(&dev) != hipSuccess || hipDeviceGetAttribute(&cus, hipDeviceAttributeMultiprocessorCount, dev) != hipSuccess) { grid = -1; return; }
        if (hipFuncSetAttribute((const void*)mega, hipFuncAttributeMaxDynamicSharedMemorySize, LDS_BYTES) != hipSuccess) { fprintf(stderr, "kernel_launch: hipFuncSetAttribute failed\n"); grid = -1; return; }
        if (hipOccupancyMaxActiveBlocksPerMultiprocessor(&per_cu, (const void*)mega, NWAVES * 64, LDS_BYTES) != hipSuccess || per_cu < 1) { fprintf(stderr, "kernel_launch: occupancy query says %d\n", per_cu); per_cu = 1; }
        (void)hipGetLastError();
        grid = cus;
    }
    if (grid < 0) return;
    const float* x = (const float*)d_in[0]; const float* ln_g = (const float*)d_in[3]; const float* ln_b = (const float*)d_in[4]; const float* b_s = (const float*)d_in[6];
    const float* hn_g = (const float*)d_in[8]; const float* g_ffn = (const float*)d_in[12]; const float* g_fin = (const float*)d_in[15];
    unsigned char* ws = (unsigned char*)d_ws; unsigned char* ob = (unsigned char*)d_out;
    bf16_t* WM = (bf16_t*)(ws + WS_WM); float* VST = (float*)(ws + WS_CTL + CTL_VST);
    bf16_t *U = (bf16_t*)(ws + WS_U), *V = (bf16_t*)(ws + WS_V), *I = (bf16_t*)(ws + WS_I), *G = (bf16_t*)(ws + WS_G);
    bf16_t *Q = (bf16_t*)(ob + OUT_Q); f16_t* F = (f16_t*)(ob + OUT_F);
    bf16_t *AACT = (bf16_t*)(ws + WS_AACT), *OACT = (bf16_t*)(ws + WS_OACT), *HN2 = (bf16_t*)(ws + WS_HN2);
    float* X1 = (float*)(ws + WS_X1); float* OUT = (float*)d_out;
    (void)x;
    (void)hipMemsetAsync(ws + WS_CTL, 0, CTL_BYTES, stream);
    Args a{}; for (int i = 0; i < 16; ++i) a.in[i] = (const float*)d_in[i]; a.out = (float*)d_out; a.ws = ws;
    launch_mega(a, 0, 10, 0, grid, stream);
}
```
